# Optimizing an MI355X kernel written in HIP

```python
import jax, jax.numpy as jnp
from jax import lax
import numpy as np

D_MODEL = 1024
BATCH = 4
SEQ = 8192
DEPTH = 1

GRID_W = 64
MEM_TOKENS = 256
MLSTM_HEADS = 4
MLSTM_QK_DIM = 64
MLSTM_V_DIM = 128
MLSTM_CHUNK = 64
MLSTM_CONV = 5
NA_HEADS = 8
NA_HEAD_DIM = 32
NA_WIN_ROWS = 8
NA_WIN_COLS = 16
MEM_HEADS = 4
MEM_HEAD_DIM = 64
N_BRANCH = 3
D_FF = 4 * D_MODEL
EPS = 1e-6

MLSTM_QK_W = MLSTM_HEADS * MLSTM_QK_DIM
MLSTM_V_W = MLSTM_HEADS * MLSTM_V_DIM
NA_W = NA_HEADS * NA_HEAD_DIM
MEM_W = MEM_HEADS * MEM_HEAD_DIM
IN_SPLITS = (2 * MLSTM_QK_W, MLSTM_V_W, MLSTM_V_W, 2 * MLSTM_HEADS, 2 * MLSTM_HEADS,
             3 * NA_W, MEM_W, N_BRANCH * D_MODEL)
D_IN = sum(IN_SPLITS)

kernel_name = 'hybrid_mlstm_natten_memxattn_block'


def rmsnorm(x, g):
    xf = x.astype(jnp.float32)
    y = xf * lax.rsqrt(jnp.mean(xf * xf, axis=-1, keepdims=True) + EPS)
    return (y * g.astype(jnp.float32)).astype(x.dtype)


def short_conv(x, w, b):
    c = x.shape[-1]
    y = lax.conv_general_dilated(
        x, w[:, None, :].astype(x.dtype), window_strides=(1,),
        padding=[(MLSTM_CONV // 2, MLSTM_CONV // 2)],
        dimension_numbers=('NWC', 'WIO', 'NWC'), feature_group_count=c)
    return y + b.astype(x.dtype)


def _mlstm_chunk_step(carry, inp):
    c_st, n_st, m_st = carry
    q, k, v, ig, lf = inp
    L = q.shape[-2]
    tril = jnp.tril(jnp.ones((L, L), dtype=bool))
    b = jnp.cumsum(lf, axis=-1)
    d_log = jnp.where(tril, b[..., :, None] - b[..., None, :] + ig[..., None, :], -jnp.inf)
    inter = b + m_st[..., None]
    m_t = jnp.maximum(inter, jnp.max(d_log, axis=-1))
    s = jnp.einsum('bhtd,bhsd->bhts', q, k) * jnp.exp(d_log - m_t[..., None])
    w_inter = jnp.exp(inter - m_t)
    num = (jnp.einsum('bhts,bhsv->bhtv', s, v)
           + w_inter[..., None] * jnp.einsum('bhvd,bhtd->bhtv', c_st, q))
    den = jnp.sum(s, axis=-1) + w_inter * jnp.einsum('bhd,bhtd->bht', n_st, q)
    h = num / jnp.maximum(jnp.abs(den), jnp.exp(-m_t))[..., None]
    b_last = b[..., -1]
    w_log = b_last[..., None] - b + ig
    m_new = jnp.maximum(b_last + m_st, jnp.max(w_log, axis=-1))
    decay = jnp.exp(b_last + m_st - m_new)
    ws = jnp.exp(w_log - m_new[..., None])
    c_new = decay[..., None, None] * c_st + jnp.einsum('bhs,bhsv,bhsd->bhvd', ws, v, k)
    n_new = decay[..., None] * n_st + jnp.einsum('bhs,bhsd->bhd', ws, k)
    return (c_new, n_new, m_new), h


def mlstm_chunkwise(q, k, v, ig, lf):
    bsz, s, nh, dk = q.shape
    dv = v.shape[-1]
    nc = s // MLSTM_CHUNK

    def chunks(a):
        a = a.reshape((bsz, nc, MLSTM_CHUNK, nh) + a.shape[3:])
        return jnp.swapaxes(jnp.moveaxis(a, 1, 0), 2, 3)

    init = (jnp.zeros((bsz, nh, dv, dk), jnp.float32),
            jnp.zeros((bsz, nh, dk), jnp.float32),
            jnp.full((bsz, nh), -jnp.inf, jnp.float32))
    _, hs = lax.scan(_mlstm_chunk_step, init,
                     (chunks(q), chunks(k), chunks(v), chunks(ig), chunks(lf)))
    return jnp.swapaxes(jnp.moveaxis(hs, 0, 1), 2, 3).reshape(bsz, s, nh, dv)


def neighbourhood_attention(q, k, v, rpb):
    bsz, s, nh, dh = q.shape
    rows = s // GRID_W
    win_r = min(NA_WIN_ROWS, rows)
    grid = lambda a: a.reshape(bsz, rows, GRID_W, nh, dh)
    qg, kg, vg = grid(q), grid(k), grid(v)
    row_start = jnp.clip(jnp.arange(rows) - win_r // 2, 0, rows - win_r)
    cols = jnp.arange(GRID_W)
    col_idx = (jnp.clip(cols - NA_WIN_COLS // 2, 0, GRID_W - NA_WIN_COLS)[:, None]
               + jnp.arange(NA_WIN_COLS))
    col_off = col_idx - cols[:, None] + (NA_WIN_COLS - 1)

    def one_row(r):
        rs = row_start[r]
        q_row = lax.dynamic_index_in_dim(qg, r, axis=1, keepdims=False)
        k_win = lax.dynamic_slice_in_dim(kg, rs, win_r, axis=1)[:, :, col_idx]
        v_win = lax.dynamic_slice_in_dim(vg, rs, win_r, axis=1)[:, :, col_idx]
        row_off = rs + jnp.arange(win_r) - r + (NA_WIN_ROWS - 1)
        bias = rpb[:, row_off[None, :, None], col_off[:, None, :]]
        sc = (jnp.einsum('bchd,bicjhd->bhcij', q_row, k_win).astype(jnp.float32)
              + bias.astype(jnp.float32)[None])
        p = jax.nn.softmax(sc.reshape(bsz, nh, GRID_W, win_r * NA_WIN_COLS), axis=-1)
        p = p.reshape(sc.shape).astype(v.dtype)
        return jnp.einsum('bhcij,bicjhd->bchd', p, v_win)

    out = lax.map(one_row, jnp.arange(rows))
    return jnp.moveaxis(out, 0, 1).reshape(bsz, s, nh * dh)


def memory_cross_attention(q, mem_n, w_mem_kv, g_mem_q, g_mem_k):
    bsz, s, _ = q.shape
    m = mem_n.shape[1]
    k, v = jnp.split(mem_n @ w_mem_kv, 2, axis=-1)
    q = rmsnorm(q.reshape(bsz, s, MEM_HEADS, MEM_HEAD_DIM), g_mem_q) * (MEM_HEAD_DIM ** -0.5)
    k = rmsnorm(k.reshape(bsz, m, MEM_HEADS, MEM_HEAD_DIM), g_mem_k)
    v = v.reshape(bsz, m, MEM_HEADS, MEM_HEAD_DIM)
    sc = jnp.einsum('bshd,bmhd->bhsm', q, k).astype(jnp.float32)
    p = jax.nn.softmax(sc, axis=-1).astype(v.dtype)
    return jnp.einsum('bhsm,bmhd->bshd', p, v).reshape(bsz, s, MEM_W)


def hybrid_layer(x, mem, g_mix, w_in, conv_w, conv_b, b_igate, b_fgate, g_mlstm, w_proj_mlstm,
                 g_na_q, g_na_k, rpb, w_proj_na, g_mem, w_mem_kv, g_mem_q, g_mem_k,
                 w_proj_mem, w_out, g_ffn, w_up, w_down):
    bsz, s, _ = x.shape
    h = rmsnorm(x, g_mix)
    z = h @ w_in
    split_idx = np.cumsum(np.array(IN_SPLITS))[:-1]
    qk_m, v_m, o_m, i_pre, f_pre, qkv_na, q_mem, gate_pre = jnp.split(z, split_idx, axis=-1)

    qk_m = jax.nn.silu(short_conv(qk_m, conv_w, conv_b))
    q_m, k_m = jnp.split(qk_m, 2, axis=-1)
    q_m = q_m.reshape(bsz, s, MLSTM_HEADS, MLSTM_QK_DIM).astype(jnp.float32) * (MLSTM_QK_DIM ** -0.5)
    k_m = k_m.reshape(bsz, s, MLSTM_HEADS, MLSTM_QK_DIM).astype(jnp.float32)
    vv = v_m.reshape(bsz, s, MLSTM_HEADS, MLSTM_V_DIM).astype(jnp.float32)
    i_log = i_pre.reshape(bsz, s, 2, MLSTM_HEADS).astype(jnp.float32) + b_igate.astype(jnp.float32)
    f_log = jax.nn.log_sigmoid(f_pre.reshape(bsz, s, 2, MLSTM_HEADS).astype(jnp.float32)
                               + b_fgate.astype(jnp.float32))
    flip = lambda a: jnp.flip(a, axis=1)
    h_fwd = mlstm_chunkwise(q_m, k_m, vv, i_log[:, :, 0], f_log[:, :, 0])
    h_bwd = flip(mlstm_chunkwise(flip(q_m), flip(k_m), flip(vv),
                                 flip(i_log[:, :, 1]), flip(f_log[:, :, 1])))
    h_m = rmsnorm(h_fwd + h_bwd, g_mlstm.reshape(MLSTM_HEADS, MLSTM_V_DIM))
    h_m = (h_m.reshape(bsz, s, MLSTM_V_W) * jax.nn.sigmoid(o_m.astype(jnp.float32))).astype(x.dtype)

    q_na, k_na, v_na = jnp.split(qkv_na.reshape(bsz, s, 3, NA_HEADS, NA_HEAD_DIM), 3, axis=2)
    q_na = rmsnorm(q_na[:, :, 0], g_na_q) * (NA_HEAD_DIM ** -0.5)
    k_na = rmsnorm(k_na[:, :, 0], g_na_k)
    h_na = neighbourhood_attention(q_na, k_na, v_na[:, :, 0], rpb)

    h_mem = memory_cross_attention(q_mem, rmsnorm(mem, g_mem), w_mem_kv, g_mem_q, g_mem_k)

    gates = jax.nn.sigmoid(gate_pre).reshape(bsz, s, N_BRANCH, D_MODEL)
    y = (gates[:, :, 0] * (h_m @ w_proj_mlstm)
         + gates[:, :, 1] * (h_na @ w_proj_na)
         + gates[:, :, 2] * (h_mem @ w_proj_mem))
    x = x + y @ w_out

    u = rmsnorm(x, g_ffn) @ w_up
    return x + jnp.square(jax.nn.relu(u)) @ w_down


def setup_inputs(seed: int = 0) -> dict:
    key = jax.random.key(seed)
    ks = jax.random.split(key, 24)
    nrm = lambda k, shape, scale: jax.random.normal(k, shape, jnp.float32) * scale
    gain = lambda k, shape: 1.0 + 0.1 * jax.random.normal(k, shape, jnp.float32)
    L = DEPTH
    f_bias = (jnp.linspace(3.0, 6.0, MLSTM_HEADS, dtype=jnp.float32)[None, None, :]
              + nrm(ks[8], (L, 2, MLSTM_HEADS), 0.1))
    return {
        'x': nrm(ks[0], (BATCH, SEQ, D_MODEL), 1.0),
        'mem': nrm(ks[1], (BATCH, MEM_TOKENS, D_MODEL), 1.0),
        'g_mix': gain(ks[2], (L, D_MODEL)),
        'w_in': nrm(ks[3], (L, D_MODEL, D_IN), D_MODEL ** -0.5),
        'conv_w': nrm(ks[4], (L, MLSTM_CONV, 2 * MLSTM_QK_W), MLSTM_CONV ** -0.5),
        'conv_b': nrm(ks[5], (L, 2 * MLSTM_QK_W), 0.02),
        'b_igate': nrm(ks[6], (L, 2, MLSTM_HEADS), 0.1),
        'b_fgate': f_bias,
        'g_mlstm': gain(ks[7], (L, MLSTM_V_W)),
        'w_proj_mlstm': nrm(ks[9], (L, MLSTM_V_W, D_MODEL), MLSTM_V_W ** -0.5),
        'g_na_q': gain(ks[10], (L, NA_HEAD_DIM)),
        'g_na_k': gain(ks[11], (L, NA_HEAD_DIM)),
        'rpb': nrm(ks[12], (L, NA_HEADS, 2 * NA_WIN_ROWS - 1, 2 * NA_WIN_COLS - 1), 0.1),
        'w_proj_na': nrm(ks[13], (L, NA_W, D_MODEL), NA_W ** -0.5),
        'g_mem': gain(ks[14], (L, D_MODEL)),
        'w_mem_kv': nrm(ks[15], (L, D_MODEL, 2 * MEM_W), D_MODEL ** -0.5),
        'g_mem_q': gain(ks[16], (L, MEM_HEAD_DIM)),
        'g_mem_k': gain(ks[17], (L, MEM_HEAD_DIM)),
        'w_proj_mem': nrm(ks[18], (L, MEM_W, D_MODEL), MEM_W ** -0.5),
        'w_out': nrm(ks[19], (L, D_MODEL, D_MODEL), D_MODEL ** -0.5),
        'g_ffn': gain(ks[20], (L, D_MODEL)),
        'w_up': nrm(ks[21], (L, D_MODEL, D_FF), D_MODEL ** -0.5),
        'w_down': nrm(ks[22], (L, D_FF, D_MODEL), D_FF ** -0.5),
    }


def reference(x, mem, g_mix, w_in, conv_w, conv_b, b_igate, b_fgate, g_mlstm, w_proj_mlstm,
              g_na_q, g_na_k, rpb, w_proj_na, g_mem, w_mem_kv, g_mem_q, g_mem_k,
              w_proj_mem, w_out, g_ffn, w_up, w_down):
    for l in range(DEPTH):
        x = hybrid_layer(x, mem, g_mix[l], w_in[l], conv_w[l], conv_b[l], b_igate[l], b_fgate[l],
                         g_mlstm[l], w_proj_mlstm[l], g_na_q[l], g_na_k[l], rpb[l], w_proj_na[l],
                         g_mem[l], w_mem_kv[l], g_mem_q[l], g_mem_k[l], w_proj_mem[l], w_out[l],
                         g_ffn[l], w_up[l], w_down[l])
    return x
```

```cpp
#include <hip/hip_runtime.h>
#include <hip/hip_cooperative_groups.h>
#include <cstdio>
#include <cstdint>
namespace cg = cooperative_groups;

#define LAS __attribute__((address_space(3)))
typedef unsigned short bf16_t;
typedef short bf16x8 __attribute__((ext_vector_type(8)));
typedef short s16x4 __attribute__((ext_vector_type(4)));
typedef short v4i16_t __attribute__((ext_vector_type(4)));
typedef float f32x4 __attribute__((ext_vector_type(4)));
typedef float f32x2 __attribute__((ext_vector_type(2)));
typedef unsigned u32x4 __attribute__((ext_vector_type(4)));
typedef unsigned u32x2 __attribute__((ext_vector_type(2)));

constexpr int NB = 4, SEQ = 8192, T = NB * SEQ, D = 1024, FF = 4096, DIN = 5648;
constexpr int ZLD = 5632;
constexpr int ZC_QK = 0, ZC_V = 512, ZC_O = 1024, ZC_QNA = 1536, ZC_QMEM = 1792, ZC_KNA = 2048, ZC_VNA = 2304, ZC_GATE = 2560;
constexpr int NIN = 5632;
constexpr float EPS = 1e-6f;
constexpr size_t MiB = 1u << 20;
constexpr size_t WS_SUMSQ = 0;
constexpr size_t WS_BAR = 512 * 1024;
constexpr size_t WS_GATES = 1 * MiB;
constexpr size_t WS_SC = 3 * MiB;
constexpr size_t WS_MS = 3 * MiB + 65536;
constexpr size_t WS_NS = 4 * MiB;
constexpr size_t WS_MEMN = 5 * MiB;
constexpr size_t WS_KV = 7 * MiB;
constexpr size_t WS_WIN = 8 * MiB;
constexpr size_t WS_WCAT = 20 * MiB;
constexpr size_t WS_WOUT = 22 * MiB;
constexpr size_t WS_WUP = 24 * MiB;
constexpr size_t WS_WDOWN = 32 * MiB;
constexpr size_t WS_WKV = 40 * MiB;
constexpr size_t WS_Z = 42 * MiB;
constexpr size_t WS_U = 42 * MiB;
constexpr size_t WS_X1B = 298 * MiB;
constexpr size_t WS_H = 394 * MiB;
constexpr size_t WS_QKC = 458 * MiB;
constexpr size_t WS_END = 490 * MiB;
constexpr int LDS_BYTES = 147456;

__device__ __forceinline__ float bf2f(unsigned short b) { return __uint_as_float((unsigned)b << 16); }
__device__ __forceinline__ float bflo(unsigned w) { return __uint_as_float(w << 16); }
__device__ __forceinline__ float bfhi(unsigned w) { return __uint_as_float(w & 0xffff0000u); }
typedef __bf16 bf16x2_t __attribute__((ext_vector_type(2)));
__device__ __forceinline__ unsigned pk2(float lo, float hi) { const f32x2 v = {lo, hi}; const bf16x2_t b = __builtin_convertvector(v, bf16x2_t); return __builtin_bit_cast(unsigned, b); }
__device__ __forceinline__ float wave_sum(float v) {
#pragma unroll
    for (int o = 1; o < 64; o <<= 1) v += __shfl_xor(v, o);
    return v;
}
__device__ __forceinline__ float wave_max(float v) {
#pragma unroll
    for (int o = 1; o < 64; o <<= 1) v = fmaxf(v, __shfl_xor(v, o));
    return v;
}
__device__ __forceinline__ float quad_sum(float v) { v += __shfl_xor(v, 16); v += __shfl_xor(v, 32); return v; }
__device__ __forceinline__ float quad_max(float v) { v = fmaxf(v, __shfl_xor(v, 16)); v = fmaxf(v, __shfl_xor(v, 32)); return v; }
__device__ __forceinline__ s16x4 trrd(LAS const unsigned char* p) { return __builtin_amdgcn_ds_read_tr16_b64_v4i16((LAS v4i16_t*)p); }
__device__ __forceinline__ bf16x8 cat8(s16x4 a, s16x4 b) { return (bf16x8){a[0], a[1], a[2], a[3], b[0], b[1], b[2], b[3]}; }
__device__ __forceinline__ bf16x8 pack8(const float* v) {
    u32x4 w; w.x = pk2(v[0], v[1]); w.y = pk2(v[2], v[3]); w.z = pk2(v[4], v[5]); w.w = pk2(v[6], v[7]);
    return __builtin_bit_cast(bf16x8, w);
}
__device__ __forceinline__ void unpack8(u32x4 w, float* v) {
    v[0] = bflo(w.x); v[1] = bfhi(w.x); v[2] = bflo(w.y); v[3] = bfhi(w.y); v[4] = bflo(w.z); v[5] = bfhi(w.z); v[6] = bflo(w.w); v[7] = bfhi(w.w);
}
__device__ __forceinline__ f32x4 mfma16(bf16x8 a, bf16x8 b, f32x4 c) { return __builtin_amdgcn_mfma_f32_16x16x32_bf16(a, b, c, 0, 0, 0); }
__device__ __forceinline__ float sigmoidf_(float x) { return __builtin_amdgcn_rcpf(1.0f + __expf(-x)); }
#define LDS_WAIT() asm volatile("s_waitcnt lgkmcnt(0)" ::: "memory")
#define LDS_BAR() do { asm volatile("s_waitcnt lgkmcnt(0)" ::: "memory"); __builtin_amdgcn_s_barrier(); asm volatile("" ::: "memory"); } while (0)

struct Args {
    const float* in[23]; float* out; unsigned char* ws;
};

namespace pg8 {
constexpr int BM = 256, BK = 64, HALF = 128, HTB = HALF * BK * 2, STAGE_BYTES = 8 * HTB, NXCD = 8, WGM = 8;
__device__ __forceinline__ int lds_byte(int r, int c) { const int st = (r >> 4) * 2 + (c >> 5), rr = r & 15, cc = c & 31, ob = rr * 64 + cc * 2; return st * 1024 + (ob ^ (((ob >> 9) & 1) << 5)); }
__device__ __forceinline__ void stage_rc(int b, int& R, int& C) { const int st = b / 1024, sb = b % 1024, swz = sb ^ (((sb >> 9) & 1) << 5); R = (st >> 1) * 16 + swz / 64; C = (st & 1) * 32 + (swz % 64) / 2; }
__device__ __forceinline__ int perm32(int rho) { const int n = rho >> 4, i = rho & 15; return 8 * (i >> 2) + 4 * n + (i & 3); }

struct Unit { int pm, pn; const char* A; const char* B; };
struct Gemm { int lda, ldb, nt, kstepA; };

struct Sched {
    int nM, nN, nwg, G, c; const char* A; const char* B; size_t tA, tB;
    int nextra, nN2, pnb2; const char* A2; const char* B2; size_t tA2, tB2;
    __device__ __forceinline__ bool next(int i, Unit& u) const {
        const long L = (long)i * G + c;
        if (L >= nwg) {
            const long j = L - nwg; if (j >= nextra) return false;
            const int pm = (int)(j / nN2), pn = (int)(j % nN2);
            u.pm = pm; u.pn = pnb2 + pn; u.A = A2 + (size_t)pm * tA2; u.B = B2 + (size_t)pn * tB2; return true;
        }
        int wgid = (int)L; { const int q = nwg / NXCD, r = nwg % NXCD, xcd = wgid % NXCD, off = wgid / NXCD; wgid = (xcd < r ? xcd * (q + 1) : r * (q + 1) + (xcd - r) * q) + off; }
        const int nig = WGM * nN, gid = wgid / nig, fm = gid * WGM, gsz = (nM - fm) < WGM ? (nM - fm) : WGM;
        u.pm = fm + ((wgid % nig) % gsz); u.pn = (wgid % nig) / gsz;
        u.A = A + (size_t)u.pm * tA; u.B = B + (size_t)u.pn * tB; return true;
    }
};

template <class Epi, bool ALIGN_EPI>
__device__ __forceinline__ void gemm_phase(LAS unsigned char* lds, const Gemm g, const Sched& S, const Epi& E) {
    int tid_ = threadIdx.x; asm volatile("" : "+v"(tid_));
    const int tid = tid_, wid = __builtin_amdgcn_readfirstlane(tid >> 6), lane = tid & 63, wr = wid >> 2, wc = wid & 3, fr = lane & 15, fq = lane >> 4;
    const int nt = g.nt;
    unsigned voffA[2], voffB[2];
#pragma unroll
    for (int i = 0; i < 2; ++i) { int R, C; stage_rc(tid * 16 + i * 8192, R, C); const int Rb = (R & ~31) + perm32(R & 31);
        voffA[i] = (unsigned)(R * g.lda + C) * 2u; voffB[i] = (unsigned)(Rb * g.ldb + C) * 2u; }
    const size_t kstep = (size_t)(BK * 2), kstepA = (size_t)g.kstepA;
    const size_t hstepA = (size_t)HALF * g.lda * 2, hstepB = (size_t)HALF * g.ldb * 2;
    const unsigned ldsw = (unsigned)wid * 1024u;
    const int aoff = lds_byte(wr * 64 + fr, fq * 8), boff = lds_byte(wc * 32 + fr, fq * 8);
#define PG8_SA(b, h) (((b) * 2 + (h)) * HTB)
#define PG8_SB(b, h) ((4 + (b) * 2 + (h)) * HTB)
#define PG8_STAGE(bufoff, gbase, voff) do { _Pragma("unroll") for (int _i = 0; _i < 2; ++_i) \
        __builtin_amdgcn_global_load_lds((const unsigned*)((const char*)(gbase) + (voff)[_i]), (LAS unsigned*)(lds + (bufoff) + ldsw + _i * 8192), 16, 0, 0); } while (0)
#define PG8_LDA(dst, b, h) do { _Pragma("unroll") for (int m = 0; m < 4; ++m) _Pragma("unroll") for (int k = 0; k < 2; ++k) dst[m][k] = *(const LAS bf16x8*)(lds + PG8_SA(b, h) + aoff + m * 2048 + k * 1024); } while (0)
#define PG8_LDB(dst, b, h) do { _Pragma("unroll") for (int n = 0; n < 2; ++n) _Pragma("unroll") for (int k = 0; k < 2; ++k) dst[n][k] = *(const LAS bf16x8*)(lds + PG8_SB(b, h) + boff + n * 2048 + k * 1024); } while (0)
#define PG8_MMA(ai, bj, At, Bt) do { __builtin_amdgcn_s_setprio(3); _Pragma("unroll") for (int m = 0; m < 4; ++m) _Pragma("unroll") for (int n = 0; n < 2; ++n) _Pragma("unroll") for (int k = 0; k < 2; ++k) \
        acc[ai][bj][m][n] = __builtin_amdgcn_mfma_f32_16x16x32_bf16(Bt[n][k], At[m][k], acc[ai][bj][m][n], 0, 0, 0); __builtin_amdgcn_s_setprio(0); } while (0)
#define PG8_WAIT_V(n) asm volatile("s_waitcnt vmcnt(" #n ")" ::: "memory")
#define PG8_WAIT_L(n) asm volatile("s_waitcnt lgkmcnt(" #n ")" ::: "memory")
#define PG8_BAR __builtin_amdgcn_s_barrier()
#define PG8_SCHED __builtin_amdgcn_sched_barrier(0)
    Unit cur, nxt; int ui = 0;
    if (!S.next(0, cur)) return;
    f32x4 acc[2][2][4][2];
#pragma unroll
    for (int a = 0; a < 2; ++a)
#pragma unroll
        for (int b = 0; b < 2; ++b)
#pragma unroll
            for (int m = 0; m < 4; ++m)
#pragma unroll
                for (int n = 0; n < 2; ++n) acc[a][b][m][n] = (f32x4){0.f, 0.f, 0.f, 0.f};
    bf16x8 At[4][2], B0[2][2], B1[2][2];
    const char* cA = cur.A; const char* cB = cur.B;
    PG8_STAGE(PG8_SB(0, 0), cB, voffB); PG8_STAGE(PG8_SB(0, 1), cB + hstepB, voffB); PG8_STAGE(PG8_SA(0, 0), cA, voffA); PG8_STAGE(PG8_SA(0, 1), cA + hstepA, voffA);
    if (wr == 1) PG8_BAR;
    PG8_WAIT_V(2); PG8_BAR;
    PG8_STAGE(PG8_SB(1, 0), cB + kstep, voffB); PG8_STAGE(PG8_SA(1, 0), cA + kstepA, voffA); PG8_STAGE(PG8_SB(1, 1), cB + hstepB + kstep, voffB);
    PG8_WAIT_V(6); PG8_BAR;
    for (;;) {
        const bool has_next = S.next(ui + 1, nxt);
        const char* nA = has_next ? nxt.A : cA; const char* nB = has_next ? nxt.B : cB;
        for (int t = 0; t < nt; t += 2) {
            const bool last = (t == nt - 2);
            const char* a1 = cA + (size_t)(t + 1) * kstepA;
            const char* a2 = last ? nA : cA + (size_t)(t + 2) * kstepA; const char* b2 = last ? nB : cB + (size_t)(t + 2) * kstep;
            const char* a3 = a2 + kstepA; const char* b3 = b2 + kstep;
            PG8_LDB(B0, 0, 0); PG8_LDB(B1, 0, 1); PG8_SCHED; PG8_LDA(At, 0, 0); PG8_STAGE(PG8_SA(1, 1), a1 + hstepA, voffA);
            PG8_WAIT_V(8); PG8_WAIT_L(0); PG8_BAR; PG8_MMA(0, 0, At, B0); PG8_MMA(0, 1, At, B1); PG8_BAR; PG8_SCHED;
            PG8_LDA(At, 0, 1); PG8_STAGE(PG8_SB(0, 0), b2, voffB); PG8_STAGE(PG8_SB(0, 1), b2 + hstepB, voffB); PG8_STAGE(PG8_SA(0, 0), a2, voffA);
            PG8_WAIT_V(8); PG8_WAIT_L(0); PG8_BAR; PG8_MMA(1, 0, At, B0); PG8_MMA(1, 1, At, B1); PG8_BAR; PG8_SCHED;
            PG8_LDB(B0, 1, 0); PG8_LDB(B1, 1, 1); PG8_SCHED; PG8_LDA(At, 1, 0); PG8_STAGE(PG8_SA(0, 1), a2 + hstepA, voffA);
            PG8_WAIT_V(8); PG8_WAIT_L(0); PG8_BAR; PG8_MMA(0, 0, At, B0); PG8_MMA(0, 1, At, B1); PG8_BAR; PG8_SCHED;
            PG8_LDA(At, 1, 1); PG8_STAGE(PG8_SB(1, 0), b3, voffB); PG8_STAGE(PG8_SB(1, 1), b3 + hstepB, voffB); PG8_STAGE(PG8_SA(1, 0), a3, voffA);
            PG8_WAIT_V(8); PG8_WAIT_L(0); PG8_BAR; PG8_MMA(1, 0, At, B0); PG8_MMA(1, 1, At, B1); PG8_BAR; PG8_SCHED;
            if constexpr (Epi::MID) { if (t + 2 == 8 || t + 2 == 12) { E.mid(acc, cur, (t + 2 == 8) ? 0 : 1, wr, wc, fr, fq); PG8_SCHED; } }
        }
        if constexpr (ALIGN_EPI) { if (wr == 0) PG8_BAR; }
        E(acc, cur, wr, wc, fr, fq);
        if (!has_next) break;
#pragma unroll
        for (int a = 0; a < 2; ++a)
#pragma unroll
            for (int b = 0; b < 2; ++b)
#pragma unroll
                for (int m = 0; m < 4; ++m)
#pragma unroll
                    for (int n = 0; n < 2; ++n) acc[a][b][m][n] = (f32x4){0.f, 0.f, 0.f, 0.f};
        cur = nxt; cA = nA; cB = nB; ++ui;
        if constexpr (ALIGN_EPI) { if (wr == 1) PG8_BAR; }
    }
    PG8_WAIT_V(0);
    if constexpr (!ALIGN_EPI) { if (wr == 0) PG8_BAR; }
    PG8_BAR;
#undef PG8_SA
#undef PG8_SB
#undef PG8_STAGE
#undef PG8_LDA
#undef PG8_LDB
#undef PG8_MMA
#undef PG8_WAIT_V
#undef PG8_WAIT_L
#undef PG8_BAR
#undef PG8_SCHED
}

__device__ __forceinline__ u32x4 pk8(f32x4 v0, f32x4 v1) { u32x4 w; w.x = pk2(v0[0], v0[1]); w.y = pk2(v0[2], v0[3]); w.z = pk2(v1[0], v1[1]); w.w = pk2(v1[2], v1[3]); return w; }
__device__ __forceinline__ f32x4 sig4(f32x4 v) { f32x4 o; o[0] = sigmoidf_(v[0]); o[1] = sigmoidf_(v[1]); o[2] = sigmoidf_(v[2]); o[3] = sigmoidf_(v[3]); return o; }

struct EpiZ {
    static constexpr bool MID = false;
    bf16_t* Z; const float* gq; const float* gk;
    __device__ __forceinline__ void operator()(const f32x4 (&acc)[2][2][4][2], const Unit& u, int wr, int wc, int fr, int fq) const {
        const int row0 = u.pm * BM + wr * 64 + fr;
        const int col0 = u.pn * BM + wc * 32 + 8 * fq;
        if (u.pn == 6 || u.pn == 8) {
            const float* g = (u.pn == 6) ? gq : gk; const float sc = (u.pn == 6) ? 0.17677669529663687f * 1.4426950408889634f : 1.0f;
            const f32x4 g0 = *(const f32x4*)(g + 8 * fq) * sc, g1 = *(const f32x4*)(g + 8 * fq + 4) * sc;
#pragma unroll
            for (int ai = 0; ai < 2; ++ai)
#pragma unroll
                for (int m = 0; m < 4; ++m) { bf16_t* rowp = Z + (size_t)(row0 + ai * HALF + m * 16) * ZLD + col0;
#pragma unroll
                    for (int bj = 0; bj < 2; ++bj) { f32x4 v0 = acc[ai][bj][m][0], v1 = acc[ai][bj][m][1];
                        float ss = (v0[0] * v0[0] + v0[1] * v0[1]) + (v0[2] * v0[2] + v0[3] * v0[3]) + (v1[0] * v1[0] + v1[1] * v1[1]) + (v1[2] * v1[2] + v1[3] * v1[3]);
                        ss = quad_sum(ss); const float rstd = rsqrtf(ss * (1.0f / 32.0f) + EPS);
                        v0 = v0 * rstd * g0; v1 = v1 * rstd * g1;
                        __builtin_nontemporal_store(pk8(v0, v1), (u32x4*)(rowp + bj * HALF)); } }
            return;
        }
        const bool sg = (u.pn == 4 || u.pn == 5 || u.pn >= 10);
#pragma unroll
        for (int ai = 0; ai < 2; ++ai)
#pragma unroll
            for (int m = 0; m < 4; ++m) { bf16_t* rowp = Z + (size_t)(row0 + ai * HALF + m * 16) * ZLD + col0;
#pragma unroll
                for (int bj = 0; bj < 2; ++bj) { f32x4 v0 = acc[ai][bj][m][0], v1 = acc[ai][bj][m][1];
                    if (sg) { v0 = sig4(v0); v1 = sig4(v1); }
                    __builtin_nontemporal_store(pk8(v0, v1), (u32x4*)(rowp + bj * HALF)); } }
    }
};

#ifndef HOOK_MB
#define HOOK_MB 4
#endif
struct EpiMerge {
    static constexpr bool MID = true;
    const bf16_t* Z; bf16_t* Y;
    __device__ __forceinline__ void mid(f32x4 (&acc)[2][2][4][2], const Unit& u, int which, int wr, int wc, int fr, int fq) const {
        int row0 = u.pm * BM + wr * 64 + fr; const int col0 = u.pn * BM + wc * 32 + 8 * fq;
        asm volatile("" : "+v"(row0));
        const bf16_t* gp0 = Z + (size_t)row0 * ZLD + ZC_GATE + which * 1024 + col0;
#pragma unroll
        for (int ai = 0; ai < 2; ++ai)
#pragma unroll
            for (int m0 = 0; m0 < 4; m0 += HOOK_MB) {
                u32x4 ga[HOOK_MB][2], gb[HOOK_MB][2];
#pragma unroll
                for (int mm = 0; mm < HOOK_MB; ++mm) { const bf16_t* gp = gp0 + (size_t)(ai * HALF + (m0 + mm) * 16) * ZLD;
#pragma unroll
                    for (int bj = 0; bj < 2; ++bj) { ga[mm][bj] = *(const u32x4*)(gp + bj * HALF); gb[mm][bj] = *(const u32x4*)(gp + 1024 + bj * HALF); } }
#pragma unroll
                for (int mm = 0; mm < HOOK_MB; ++mm)
#pragma unroll
                    for (int bj = 0; bj < 2; ++bj) { float a[8], b[8]; unpack8(ga[mm][bj], a); unpack8(gb[mm][bj], b);
#pragma unroll
                        for (int e = 0; e < 8; ++e) { const float r = a[e] * __builtin_amdgcn_rcpf(fmaxf(b[e], 1e-30f)); acc[ai][bj][m0 + mm][e >> 2][e & 3] *= r; } }
                asm volatile("" ::: "memory"); }
    }
    __device__ __forceinline__ void operator()(const f32x4 (&acc)[2][2][4][2], const Unit& u, int wr, int wc, int fr, int fq) const {
        const int row0 = u.pm * BM + wr * 64 + fr, col0 = u.pn * BM + wc * 32 + 8 * fq;
#pragma unroll
        for (int ai = 0; ai < 2; ++ai)
#pragma unroll
            for (int m = 0; m < 4; ++m) { const size_t r = (size_t)(row0 + ai * HALF + m * 16);
#pragma unroll
                for (int bj = 0; bj < 2; ++bj) { const u32x4 gc = *(const u32x4*)(Z + r * ZLD + ZC_GATE + 2048 + col0 + bj * HALF);
                    float c[8]; unpack8(gc, c); f32x4 v0 = acc[ai][bj][m][0], v1 = acc[ai][bj][m][1];
#pragma unroll
                    for (int e = 0; e < 4; ++e) { v0[e] *= fmaxf(c[e], 1e-30f); v1[e] *= fmaxf(c[4 + e], 1e-30f); }
                    *(u32x4*)(Y + r * D + col0 + bj * HALF) = pk8(v0, v1); } }
    }
};

struct EpiX1 {
    static constexpr bool MID = false;
    const float* x; float* out; bf16_t* x1b; float* sumsq;
    __device__ __forceinline__ void operator()(const f32x4 (&acc)[2][2][4][2], const Unit& u, int wr, int wc, int fr, int fq) const {
        const int row0 = u.pm * BM + wr * 64 + fr, col0 = u.pn * BM + wc * 32 + 8 * fq;
#pragma unroll
        for (int ai = 0; ai < 2; ++ai)
#pragma unroll
            for (int m = 0; m < 4; ++m) { const size_t r = (size_t)(row0 + ai * HALF + m * 16); float ss = 0.f;
#pragma unroll
                for (int bj = 0; bj < 2; ++bj) { const size_t o = r * D + col0 + bj * HALF;
                    const f32x4 v0 = *(const f32x4*)(x + o) + acc[ai][bj][m][0], v1 = *(const f32x4*)(x + o + 4) + acc[ai][bj][m][1];
                    *(u32x4*)(x1b + o) = pk8(v0, v1);
                    ss += (v0[0] * v0[0] + v0[1] * v0[1]) + (v0[2] * v0[2] + v0[3] * v0[3]) + (v1[0] * v1[0] + v1[1] * v1[1]) + (v1[2] * v1[2] + v1[3] * v1[3]); }
                ss = quad_sum(ss);
                if (fq == 0) atomicAdd(sumsq + r, ss); }
    }
};

struct EpiUp {
    static constexpr bool MID = false;
    const float* sumsq; bf16_t* U;
    __device__ __forceinline__ void operator()(const f32x4 (&acc)[2][2][4][2], const Unit& u, int wr, int wc, int fr, int fq) const {
        const int row0 = u.pm * BM + wr * 64 + fr, col0 = u.pn * BM + wc * 32 + 8 * fq;
#pragma unroll
        for (int ai = 0; ai < 2; ++ai)
#pragma unroll
            for (int m = 0; m < 4; ++m) { const size_t r = (size_t)(row0 + ai * HALF + m * 16); const float rstd = rsqrtf(sumsq[r] * (1.0f / D) + EPS);
#pragma unroll
                for (int bj = 0; bj < 2; ++bj) { f32x4 v0 = acc[ai][bj][m][0] * rstd, v1 = acc[ai][bj][m][1] * rstd;
#pragma unroll
                    for (int e = 0; e < 4; ++e) { const float a = fmaxf(v0[e], 0.f), b = fmaxf(v1[e], 0.f); v0[e] = a * a; v1[e] = b * b; }
                    const int colt = wc * 32 + 8 * fq + bj * HALF, kt = u.pn * 4 + (colt >> 6), rin = (int)(r - (size_t)u.pm * BM);
                    __builtin_nontemporal_store(pk8(v0, v1), (u32x4*)(U + ((size_t)(u.pm * 64 + kt) * 256 + rin) * 64 + (colt & 63))); } }
    }
};

struct EpiDown {
    static constexpr bool MID = false;
    float* out; const bf16_t* x1b;
    __device__ __forceinline__ void operator()(const f32x4 (&acc)[2][2][4][2], const Unit& u, int wr, int wc, int fr, int fq) const {
        const int row0 = u.pm * BM + wr * 64 + fr, col0 = u.pn * BM + wc * 32 + 8 * fq;
#pragma unroll
        for (int ai = 0; ai < 2; ++ai)
#pragma unroll
            for (int m = 0; m < 4; ++m) { const size_t r = (size_t)(row0 + ai * HALF + m * 16);
#pragma unroll
                for (int bj = 0; bj < 2; ++bj) { const size_t o = r * D + col0 + bj * HALF;
                    float xb[8]; unpack8(*(const u32x4*)(x1b + o), xb);
                    f32x4 v0 = acc[ai][bj][m][0], v1 = acc[ai][bj][m][1];
#pragma unroll
                    for (int e = 0; e < 4; ++e) { v0[e] += xb[e]; v1[e] += xb[4 + e]; }
                    __builtin_nontemporal_store(v0, (f32x4*)(out + o)); __builtin_nontemporal_store(v1, (f32x4*)(out + o + 4)); } }
    }
};
}

__device__ __forceinline__ void tr_item(const float* W, int ldw, int src_col, int nvalid, const float* kscale, bf16_t* WT, int ldt, int dst_row, int dst_k, LAS float* scr, int lane) {
#pragma unroll 16
    for (int i = 0; i < 32; ++i) { const int kk = 2 * i + (lane >> 5), n = lane & 31;
        float v = (n < nvalid) ? __builtin_nontemporal_load(W + (size_t)kk * ldw + src_col + n) : 0.f;
        if (kscale) v *= kscale[kk];
        scr[kk * 33 + n] = v; }
    LDS_WAIT(); asm volatile("" ::: "memory");
    const int c = lane & 7;
#pragma unroll
    for (int j = 0; j < 4; ++j) { const int n = (lane >> 3) + 8 * j; const LAS float* s = scr + (8 * c) * 33 + n;
        u32x4 o; o.x = pk2(s[0 * 33], s[1 * 33]); o.y = pk2(s[2 * 33], s[3 * 33]); o.z = pk2(s[4 * 33], s[5 * 33]); o.w = pk2(s[6 * 33], s[7 * 33]);
        *(u32x4*)(WT + (size_t)(dst_row + n) * ldt + dst_k + 8 * c) = o; }
    LDS_WAIT(); asm volatile("" ::: "memory");
}
template <int NR>
__device__ __forceinline__ void rms_rows(const float* xrow, const float* g, bf16_t* orow, int lane) {
    f32x4 v[NR][4]; float s[NR];
#pragma unroll
    for (int r = 0; r < NR; ++r)
#pragma unroll
        for (int j = 0; j < 4; ++j) v[r][j] = __builtin_nontemporal_load(((const f32x4*)(xrow + (size_t)r * D)) + lane + 64 * j);
    f32x4 gv[4];
#pragma unroll
    for (int j = 0; j < 4; ++j) gv[j] = ((const f32x4*)g)[lane + 64 * j];
#pragma unroll
    for (int r = 0; r < NR; ++r) { s[r] = 0.f;
#pragma unroll
        for (int j = 0; j < 4; ++j) s[r] += (v[r][j][0] * v[r][j][0] + v[r][j][1] * v[r][j][1]) + (v[r][j][2] * v[r][j][2] + v[r][j][3] * v[r][j][3]); }
#pragma unroll
    for (int o = 1; o < 64; o <<= 1)
#pragma unroll
        for (int r = 0; r < NR; ++r) s[r] += __shfl_xor(s[r], o);
#pragma unroll
    for (int r = 0; r < NR; ++r) { const float rstd = rsqrtf(s[r] * (1.0f / D) + EPS);
#pragma unroll
        for (int j = 0; j < 4; ++j) { const f32x4 o = v[r][j] * rstd * gv[j];
            u32x2 w; w.x = pk2(o[0], o[1]); w.y = pk2(o[2], o[3]); ((u32x2*)(orow + (size_t)r * D))[lane + 64 * j] = w; } }
}
__device__ __forceinline__ void p0_prep(const Args& a, LAS unsigned char* lds, int G) {
    int tid_ = threadIdx.x; asm volatile("" : "+v"(tid_));
    const int tid = tid_, lane = tid & 63, wave = tid >> 6;
    LAS float* scr = (LAS float*)(lds + wave * 16384);
    const int gw = blockIdx.x * 8 + wave, NGW = G * 8;
    unsigned char* ws = a.ws;
    constexpr int I_IN = 16 * 177, I_CAT = 512, I_OUT = 512, I_UP = 2048, I_DN = 2048, I_KV = 256;
    constexpr int NITEMS = I_IN + I_CAT + I_OUT + I_UP + I_DN + I_KV;
    for (int it = gw; it < NITEMS; it += NGW) {
        int r = it;
        if (r < I_IN) { const int kb = r / 177, nb = r % 177, n0 = 32 * nb; int src, nv = 32;
            if (n0 < 1536) src = n0; else if (n0 < 1792) src = 1552 + (n0 - 1536); else if (n0 < 2048) src = 2320 + (n0 - 1792); else if (n0 < 2560) src = 1808 + (n0 - 2048);
            else if (n0 < 5632) src = 2576 + (n0 - 2560); else if (n0 == 5632) { src = 1536; nv = 16; } else { src = 0; nv = 0; }
            tr_item(a.in[3] + (size_t)(64 * kb) * DIN, DIN, src, nv, nullptr, (bf16_t*)(ws + WS_WIN), 1024, n0, 64 * kb, scr, lane); continue; }
        r -= I_IN;
        if (r < I_CAT) { const float* W; int kb, nb, dk;
            if (r < 256) { W = a.in[9]; kb = r / 32; nb = r % 32; dk = 0; } else if (r < 384) { W = a.in[13]; kb = (r - 256) / 32; nb = r % 32; dk = 512; } else { W = a.in[18]; kb = (r - 384) / 32; nb = r % 32; dk = 768; }
            tr_item(W + (size_t)(64 * kb) * D, D, 32 * nb, 32, nullptr, (bf16_t*)(ws + WS_WCAT), 1024, 32 * nb, dk + 64 * kb, scr, lane); continue; }
        r -= I_CAT;
        if (r < I_OUT) { const int kb = r / 32, nb = r % 32;
            tr_item(a.in[19] + (size_t)(64 * kb) * D, D, 32 * nb, 32, nullptr, (bf16_t*)(ws + WS_WOUT), 1024, 32 * nb, 64 * kb, scr, lane); continue; }
        r -= I_OUT;
        if (r < I_UP) { const int kb = r / 128, nb = r % 128;
            tr_item(a.in[21] + (size_t)(64 * kb) * FF, FF, 32 * nb, 32, a.in[20] + 64 * kb, (bf16_t*)(ws + WS_WUP), 1024, 32 * nb, 64 * kb, scr, lane); continue; }
        r -= I_UP;
        if (r < I_DN) { const int kb = r / 32, nb = r % 32;
            tr_item(a.in[22] + (size_t)(64 * kb) * D, D, 32 * nb, 32, nullptr, (bf16_t*)(ws + WS_WDOWN), 4096, 32 * nb, 64 * kb, scr, lane); continue; }
        r -= I_DN;
        { const int kb = r / 16, nb = r % 16;
            tr_item(a.in[15] + (size_t)(64 * kb) * 512, 512, 32 * nb, 32, nullptr, (bf16_t*)(ws + WS_WKV), 1024, 32 * nb, 64 * kb, scr, lane); }
    }
    for (int m = gw * 4; m < T; m += NGW * 4) rms_rows<4>(a.in[0] + (size_t)m * D, a.in[2], (bf16_t*)(ws + WS_H) + (size_t)m * D, lane);
    for (int m = gw; m < NB * 256; m += NGW) rms_rows<1>(a.in[1] + (size_t)m * D, a.in[14], (bf16_t*)(ws + WS_MEMN) + (size_t)m * D, lane);
    float* sumsq = (float*)(ws + WS_SUMSQ);
    for (int i = blockIdx.x * 512 + tid; i < T; i += G * 512) sumsq[i] = 0.f;
}

__device__ __forceinline__ void gates_unit(const Args& a, int pm) {
    int tid_ = threadIdx.x; asm volatile("" : "+v"(tid_));
    const int w = tid_ >> 6, lane = tid_ & 63, fr = lane & 15, fq = lane >> 4;
    const bf16_t* H = (const bf16_t*)(a.ws + WS_H); const bf16_t* Wg = (const bf16_t*)(a.ws + WS_WIN) + (size_t)5632 * 1024;
    const int r0 = pm * 256 + 32 * w;
    f32x4 acc[2] = {{0.f, 0.f, 0.f, 0.f}, {0.f, 0.f, 0.f, 0.f}};
    const bf16_t* wp = Wg + (size_t)fr * 1024 + 8 * fq; const bf16_t* hp0 = H + (size_t)(r0 + fr) * 1024 + 8 * fq; const bf16_t* hp1 = hp0 + (size_t)16 * 1024;
#pragma unroll 8
    for (int kk = 0; kk < 32; ++kk) { const bf16x8 bw = *(const bf16x8*)(wp + 32 * kk);
        acc[0] = mfma16(bw, *(const bf16x8*)(hp0 + 32 * kk), acc[0]); acc[1] = mfma16(bw, *(const bf16x8*)(hp1 + 32 * kk), acc[1]); }
    float* gates = (float*)(a.ws + WS_GATES);
    *(f32x4*)(gates + (size_t)(r0 + fr) * 16 + 4 * fq) = acc[0];
    *(f32x4*)(gates + (size_t)(r0 + 16 + fr) * 16 + 4 * fq) = acc[1];
}
__device__ __forceinline__ void kv_unit(const Args& a, int u) {
    int tid_ = threadIdx.x; asm volatile("" : "+v"(tid_));
    const int w = tid_ >> 6, lane = tid_ & 63, fr = lane & 15, fq = lane >> 4;
    const bf16_t* Mn = (const bf16_t*)(a.ws + WS_MEMN); const bf16_t* Wk = (const bf16_t*)(a.ws + WS_WKV);
    const int row = (u >> 2) * 64 + 16 * (w & 3) + fr, cbase = (u & 3) * 128 + 64 * (w >> 2);
    f32x4 acc[4];
#pragma unroll
    for (int nt = 0; nt < 4; ++nt) acc[nt] = (f32x4){0.f, 0.f, 0.f, 0.f};
    const bf16_t* ap = Mn + (size_t)row * 1024 + 8 * fq; const bf16_t* bp = Wk + (size_t)(cbase + fr) * 1024 + 8 * fq;
#pragma unroll 4
    for (int kk = 0; kk < 32; ++kk) { const bf16x8 av = *(const bf16x8*)(ap + 32 * kk);
#pragma unroll
        for (int nt = 0; nt < 4; ++nt) acc[nt] = mfma16(*(const bf16x8*)(bp + (size_t)nt * 16 * 1024 + 32 * kk), av, acc[nt]); }
    bf16_t* KV = (bf16_t*)(a.ws + WS_KV);
#pragma unroll
    for (int nt = 0; nt < 4; ++nt) { u32x2 o; o.x = pk2(acc[nt][0], acc[nt][1]); o.y = pk2(acc[nt][2], acc[nt][3]);
        *(u32x2*)(KV + (size_t)row * 512 + cbase + 16 * nt + 4 * fq) = o; }
}

struct GateS { float lf, ig, P, Btot; };
__device__ __forceinline__ GateS gate_scalars(const float* gates, const float* b_i, const float* b_f, int tok0, int hd, int dir, int lane) {
    GateS g;
    const float f = gates[(size_t)(tok0 + lane) * 16 + 8 + dir * 4 + hd] + b_f[dir * 4 + hd];
    g.ig = gates[(size_t)(tok0 + lane) * 16 + dir * 4 + hd] + b_i[dir * 4 + hd];
    g.lf = fminf(f, 0.f) - log1pf(__expf(-fabsf(f)));
    float p = g.lf;
#pragma unroll
    for (int o = 1; o < 64; o <<= 1) { const float t = __shfl_up(p, o); if (lane >= o) p += t; }
    g.P = p; g.Btot = __shfl(p, 63);
    return g;
}

constexpr int ML_VS = 272, ML_KS = 144;
constexpr int ML_VIMG = 0, ML_KIMG = 64 * ML_VS, ML_SCAL = ML_KIMG + 2 * 64 * ML_KS, ML_HEAD = ML_SCAL + 2048;

__device__ __forceinline__ void mlstm_local_unit(const Args& a, LAS unsigned char* lds, int unit) {
    int tid_ = threadIdx.x; asm volatile("" : "+v"(tid_));
    const int tid = tid_, lane = tid & 63, w = tid >> 6, hs = w >> 2, hw = w & 3, ht = tid & 255;
    const int hp = unit & 1, c = (unit >> 1) & 127, b = unit >> 8, hd = 2 * hp + hs;
    const int tok0 = b * SEQ + c * 64;
    unsigned char* ws = a.ws;
    const bf16_t* Z = (const bf16_t*)(ws + WS_Z); bf16_t* QKC = (bf16_t*)(ws + WS_QKC);
    LAS unsigned char* L = lds + hs * ML_HEAD;
    LAS float* WSC = (LAS float*)(L + ML_SCAL);
    if (hw < 2) {
        const int dir = hw;
        const GateS g = gate_scalars((const float*)(ws + WS_GATES), a.in[6], a.in[7], tok0, hd, dir, lane);
        const float wlog = dir == 0 ? (g.Btot - g.P + g.ig) : (g.P - g.lf + g.ig);
        const float mloc = wave_max(wlog);
        WSC[dir * 64 + lane] = __expf(wlog - mloc);
        if (lane == 0) { float* sc = (float*)(ws + WS_SC) + (size_t)((((b * 4 + hd) * 2 + dir) * 128 + c)) * 2; sc[0] = mloc; sc[1] = g.Btot; }
    }
#pragma unroll
    for (int i = 0; i < 4; ++i) { const int q = ht + 256 * i, row = q >> 4, ch = q & 15;
        const u32x4 v = *(const u32x4*)(Z + (size_t)(tok0 + row) * ZLD + ZC_V + 128 * hd + 8 * ch);
        *(LAS u32x4*)(L + ML_VIMG + row * ML_VS + ch * 16) = v; }
    LDS_BAR();
    {
        const int ch = ht & 15, tg = ht >> 4;
        const bool isk = ch >= 8;
        const int cidx = isk ? 256 + 64 * hd + 8 * (ch - 8) : 64 * hd + 8 * ch;
        float xr[8][8];
        u32x4 xraw[8];
#pragma unroll
        for (int r = 0; r < 8; ++r) { const int s = 4 * tg - 2 + r, pos = c * 64 + s; const int sc_ = pos < 0 ? s - pos : (pos >= SEQ ? s - (pos - SEQ + 1) : s);
            xraw[r] = *(const u32x4*)(Z + (size_t)(tok0 + sc_) * ZLD + ZC_QK + cidx); }
#pragma unroll
        for (int r = 0; r < 8; ++r) { const int s = 4 * tg - 2 + r, pos = c * 64 + s; const bool ok = pos >= 0 && pos < SEQ;
            unpack8(xraw[r], xr[r]);
#pragma unroll
            for (int e = 0; e < 8; ++e) xr[r][e] = ok ? xr[r][e] : 0.f; }
        float cw[5][8], cb[8];
#pragma unroll
        for (int j = 0; j < 5; ++j) { const f32x4 w0 = *(const f32x4*)(a.in[4] + j * 512 + cidx), w1 = *(const f32x4*)(a.in[4] + j * 512 + cidx + 4);
#pragma unroll
            for (int e = 0; e < 4; ++e) { cw[j][e] = w0[e]; cw[j][4 + e] = w1[e]; } }
        { const f32x4 b0 = *(const f32x4*)(a.in[5] + cidx), b1 = *(const f32x4*)(a.in[5] + cidx + 4);
#pragma unroll
            for (int e = 0; e < 4; ++e) { cb[e] = b0[e]; cb[4 + e] = b1[e]; } }
#pragma unroll
        for (int o = 0; o < 4; ++o) { const int s = 4 * tg + o; float y[8];
#pragma unroll
            for (int e = 0; e < 8; ++e) { float acc = cb[e];
#pragma unroll
                for (int j = 0; j < 5; ++j) acc += cw[j][e] * xr[o + j][e];
                y[e] = acc * __builtin_amdgcn_rcpf(1.0f + __expf(-acc)); }
            if (!isk) {
#pragma unroll
                for (int e = 0; e < 8; ++e) y[e] *= 0.125f;
                *(bf16x8*)(QKC + (size_t)(tok0 + s) * 512 + cidx) = pack8(y);
            } else {
                *(bf16x8*)(QKC + (size_t)(tok0 + s) * 512 + cidx) = pack8(y);
#pragma unroll
                for (int dir = 0; dir < 2; ++dir) { const float wsv = WSC[dir * 64 + s]; float z[8];
#pragma unroll
                    for (int e = 0; e < 8; ++e) z[e] = y[e] * wsv;
                    *(LAS bf16x8*)(L + ML_KIMG + dir * 64 * ML_KS + s * ML_KS + (ch - 8) * 16) = pack8(z); }
            } }
    }
    LDS_BAR();
    if (ht < 128) { const int dir = ht >> 6, d = ht & 63; float n = 0.f;
        for (int s = 0; s < 64; ++s) n += bf2f(*(LAS const bf16_t*)(L + ML_KIMG + dir * 64 * ML_KS + s * ML_KS + d * 2));
        ((float*)(ws + WS_NS))[(size_t)((((b * 4 + hd) * 2 + dir) * 128 + c)) * 64 + d] = n; }
    {
        const int fr = lane & 15, fq = lane >> 4, q4 = (lane & 15) >> 2, p4 = lane & 3;
        bf16_t* CS = (bf16_t*)(ws + WS_H);
#pragma unroll
        for (int dir = 0; dir < 2; ++dir) {
            bf16x8 af[2];
#pragma unroll
            for (int kk = 0; kk < 2; ++kk) { LAS const unsigned char* p = L + ML_KIMG + dir * 64 * ML_KS + (32 * kk + 8 * fq + q4) * ML_KS + (16 * hw + 4 * p4) * 2;
                af[kk] = cat8(trrd(p), trrd(p + 4 * ML_KS)); }
            bf16_t* cs = CS + (size_t)((((b * 4 + hd) * 2 + dir) * 128 + c)) * 8192;
#pragma unroll
            for (int vt = 0; vt < 8; ++vt) { f32x4 acc = {0.f, 0.f, 0.f, 0.f};
#pragma unroll
                for (int kk = 0; kk < 2; ++kk) { LAS const unsigned char* p = L + ML_VIMG + (32 * kk + 8 * fq + q4) * ML_VS + (16 * vt + 4 * p4) * 2;
                    acc = mfma16(af[kk], cat8(trrd(p), trrd(p + 4 * ML_VS)), acc); }
                u32x2 o; o.x = pk2(acc[0], acc[1]); o.y = pk2(acc[2], acc[3]);
                *(u32x2*)(cs + (16 * vt + fr) * 64 + 16 * hw + 4 * fq) = o; }
        }
    }
    LDS_BAR();
}

__device__ __forceinline__ void scan_step(const f32x2 sc, float& m, float& decay, float& scale) {
    const float mloc = sc[0], Bt = sc[1];
    const float mn = fmaxf(Bt + m, mloc); decay = __expf(Bt + m - mn); scale = __expf(mloc - mn); m = mn;
}
__device__ __forceinline__ void mlstm_scan(const Args& a, int G) {
    unsigned char* ws = a.ws;
    const float* SC = (const float*)(ws + WS_SC); float* MS = (float*)(ws + WS_MS); float* NS = (float*)(ws + WS_NS); unsigned* CS = (unsigned*)(ws + WS_H);
    const float NINF = -__builtin_inff();
    int tid_ = threadIdx.x; asm volatile("" : "+v"(tid_));
    constexpr int SB = 16;
    for (int idx = blockIdx.x * 512 + tid_; idx < 131072; idx += G * 512) {
        const int chain = idx >> 12, e = idx & 4095, dir = chain & 1;
        const long cstep = dir ? -1 : 1; const size_t c0 = (size_t)chain * 128 + (dir ? 127 : 0);
        float m = NINF, s0 = 0.f, s1 = 0.f;
        for (int st0 = 0; st0 < 128; st0 += SB) {
            unsigned loc[SB]; f32x2 sc[SB];
            unsigned* p = CS + (size_t)((long)c0 + cstep * st0) * 4096 + e; const float* q = SC + (size_t)((long)c0 + cstep * st0) * 2;
#pragma unroll
            for (int j = 0; j < SB; ++j) { loc[j] = p[(long)j * cstep * 4096]; sc[j] = *(const f32x2*)(q + (long)j * cstep * 2); }
#pragma unroll
            for (int j = 0; j < SB; ++j) { float decay, scale; const float mprev = m; scan_step(sc[j], m, decay, scale);
                p[(long)j * cstep * 4096] = pk2(s0, s1); s0 = decay * s0 + scale * bflo(loc[j]); s1 = decay * s1 + scale * bfhi(loc[j]);
                if (e == 0) MS[(long)c0 + cstep * (st0 + j)] = mprev; }
        }
    }
    for (int idx = blockIdx.x * 512 + tid_; idx < 2048; idx += G * 512) {
        const int chain = idx >> 6, e = idx & 63, dir = chain & 1;
        const long cstep = dir ? -1 : 1; const size_t c0 = (size_t)chain * 128 + (dir ? 127 : 0);
        float m = NINF, s0 = 0.f;
        for (int st0 = 0; st0 < 128; st0 += SB) {
            float nl[SB]; f32x2 sc[SB];
            float* p = NS + (size_t)((long)c0 + cstep * st0) * 64 + e; const float* q = SC + (size_t)((long)c0 + cstep * st0) * 2;
#pragma unroll
            for (int j = 0; j < SB; ++j) { nl[j] = p[(long)j * cstep * 64]; sc[j] = *(const f32x2*)(q + (long)j * cstep * 2); }
#pragma unroll
            for (int j = 0; j < SB; ++j) { float decay, scale; scan_step(sc[j], m, decay, scale);
                p[(long)j * cstep * 64] = s0; s0 = decay * s0 + scale * nl[j]; }
        }
    }
}

__device__ __forceinline__ void mlstm_out_unit(const Args& a, LAS unsigned char* lds, int unit, bool dummy = false) {
    int tid_ = threadIdx.x; asm volatile("" : "+v"(tid_));
    const int tid = tid_, lane = tid & 63, w = tid >> 6, hs = w >> 2, hw = w & 3, ht = tid & 255;
    const int hp = unit & 1, c = (unit >> 1) & 127, b = unit >> 8, hd = 2 * hp + hs;
    const int tok0 = b * SEQ + c * 64;
    unsigned char* ws = a.ws;
    bf16_t* Z = (bf16_t*)(ws + WS_Z); const bf16_t* QKC = (const bf16_t*)(ws + WS_QKC);
    LAS unsigned char* L = lds + hs * ML_HEAD;
    LAS float* SA = (LAS float*)(L + ML_SCAL);
    const float* MS = (const float*)(ws + WS_MS);
    const int tt = hw, fr = lane & 15, fq = lane >> 4, q4 = (lane & 15) >> 2, p4 = lane & 3;
    const int t = 16 * tt + fr;
    bf16x8 qf[2], kfr[4][2];
#pragma unroll
    for (int kk = 0; kk < 2; ++kk) qf[kk] = *(const bf16x8*)(QKC + (size_t)(tok0 + t) * 512 + 64 * hd + 32 * kk + 8 * fq);
#pragma unroll
    for (int st = 0; st < 4; ++st)
#pragma unroll
        for (int kk = 0; kk < 2; ++kk) kfr[st][kk] = *(const bf16x8*)(QKC + (size_t)(tok0 + 16 * st + fr) * 512 + 256 + 64 * hd + 32 * kk + 8 * fq);
    f32x4 nsv[2][4];
#pragma unroll
    for (int dir = 0; dir < 2; ++dir) { const float* ns = (const float*)(ws + WS_NS) + (size_t)(((b * 4 + hd) * 2 + dir) * 128 + c) * 64;
#pragma unroll
        for (int kk = 0; kk < 2; ++kk) { nsv[dir][2 * kk] = *(const f32x4*)(ns + 32 * kk + 8 * fq); nsv[dir][2 * kk + 1] = *(const f32x4*)(ns + 32 * kk + 8 * fq + 4); } }
    bf16_t* orow = Z + (size_t)(tok0 + t) * ZLD + ZC_O + 128 * hd;
    u32x2 ogv[8];
#pragma unroll
    for (int vt = 0; vt < 8; ++vt) ogv[vt] = *(const u32x2*)(orow + 16 * vt + 4 * fq);
    f32x4 sacc[4];
#pragma unroll
    for (int st = 0; st < 4; ++st) { sacc[st] = (f32x4){0.f, 0.f, 0.f, 0.f};
#pragma unroll
        for (int kk = 0; kk < 2; ++kk) sacc[st] = mfma16(kfr[st][kk], qf[kk], sacc[st]); }
    if (hw < 2) {
        const int dir = hw;
        const GateS g = gate_scalars((const float*)(ws + WS_GATES), a.in[6], a.in[7], tok0, hd, dir, lane);
        const float bcum = dir == 0 ? g.P : (g.Btot - g.P + g.lf);
        const float as = g.ig - bcum;
        const float mst = MS[(size_t)(((b * 4 + hd) * 2 + dir) * 128 + c)];
        float cm = as;
        if (dir == 0) {
#pragma unroll
            for (int o = 1; o < 64; o <<= 1) { const float t = __shfl_up(cm, o); if (lane >= o) cm = fmaxf(cm, t); }
        } else {
#pragma unroll
            for (int o = 1; o < 64; o <<= 1) { const float t = __shfl_down(cm, o); if (lane + o < 64) cm = fmaxf(cm, t); }
        }
        SA[(dir * 3 + 0) * 64 + lane] = as; SA[(dir * 3 + 1) * 64 + lane] = fmaxf(cm, mst); SA[(dir * 3 + 2) * 64 + lane] = bcum;
        if (lane == 0) SA[6 * 64 + dir] = mst;
    }
#pragma unroll
    for (int i = 0; i < 4; ++i) { const int q = ht + 256 * i, row = q >> 4, ch = q & 15;
        const u32x4 v = *(const u32x4*)(Z + (size_t)(tok0 + row) * ZLD + ZC_V + 128 * hd + 8 * ch);
        *(LAS u32x4*)(L + ML_VIMG + row * ML_VS + ch * 16) = v; }
    LDS_BAR();
    {
        float qv[16];
        { unpack8(__builtin_bit_cast(u32x4, qf[0]), qv); unpack8(__builtin_bit_cast(u32x4, qf[1]), qv + 8); }
        f32x4 hsum[8];
#pragma unroll
        for (int vt = 0; vt < 8; ++vt) hsum[vt] = (f32x4){0.f, 0.f, 0.f, 0.f};
#pragma unroll 1
        for (int dir = 0; dir < 2; ++dir) {
            const size_t cc = (size_t)(((b * 4 + hd) * 2 + dir) * 128 + c);
            const float amax = SA[(dir * 3 + 1) * 64 + t], bq = SA[(dir * 3 + 2) * 64 + t], mst = SA[6 * 64 + dir];
            const float winter = __expf(mst - amax);
            float p[4][4]; float den = 0.f;
#pragma unroll
            for (int st = 0; st < 4; ++st) { const f32x4 a4 = *(LAS const f32x4*)(SA + (dir * 3 + 0) * 64 + 16 * st + 4 * fq);
#pragma unroll
                for (int j = 0; j < 4; ++j) { const int s = 16 * st + 4 * fq + j; const bool valid = dir == 0 ? (s <= t) : (s >= t);
                    const float e = __expf(fminf(a4[j] - amax, 0.f));
                    p[st][j] = valid ? sacc[st][j] * e : 0.f; den += p[st][j]; } }
            den = quad_sum(den);
            bf16x8 pb[2];
#pragma unroll
            for (int kk = 0; kk < 2; ++kk) { float v8[8];
#pragma unroll
                for (int j = 0; j < 4; ++j) { v8[j] = p[2 * kk][j]; v8[4 + j] = p[2 * kk + 1][j]; }
                pb[kk] = pack8(v8); }
            float dot = 0.f;
#pragma unroll
            for (int kk = 0; kk < 2; ++kk) { const f32x4 n0 = dir ? nsv[1][2 * kk] : nsv[0][2 * kk], n1 = dir ? nsv[1][2 * kk + 1] : nsv[0][2 * kk + 1];
#pragma unroll
                for (int j = 0; j < 4; ++j) dot += qv[8 * kk + j] * n0[j] + qv[8 * kk + 4 + j] * n1[j]; }
            dot = quad_sum(dot);
            const float dent = den + winter * dot;
            const float inv = __builtin_amdgcn_rcpf(fmaxf(fabsf(dent), __expf(-(bq + amax))));
            const bf16_t* cs = (const bf16_t*)(ws + WS_H) + cc * 8192;
#pragma unroll
            for (int vt = 0; vt < 8; ++vt) { f32x4 a1 = {0.f, 0.f, 0.f, 0.f}, a2 = {0.f, 0.f, 0.f, 0.f};
#pragma unroll
                for (int kk = 0; kk < 2; ++kk) { LAS const unsigned char* pp = L + ML_VIMG + (32 * kk + 4 * fq + q4) * ML_VS + (16 * vt + 4 * p4) * 2;
                    a1 = mfma16(cat8(trrd(pp), trrd(pp + 16 * ML_VS)), pb[kk], a1);
                    const bf16x8 cf = *(const bf16x8*)(cs + (16 * vt + fr) * 64 + 32 * kk + 8 * fq);
                    a2 = mfma16(cf, qf[kk], a2); }
                hsum[vt] += (a1 + a2 * winter) * inv; }
        }
        float ss = 0.f;
#pragma unroll
        for (int vt = 0; vt < 8; ++vt) ss += (hsum[vt][0] * hsum[vt][0] + hsum[vt][1] * hsum[vt][1]) + (hsum[vt][2] * hsum[vt][2] + hsum[vt][3] * hsum[vt][3]);
        ss = quad_sum(ss);
        const float rstd = rsqrtf(ss * (1.0f / 128.0f) + EPS);
        const float* gm = a.in[8] + 128 * hd;
#pragma unroll
        for (int vt = 0; vt < 8; ++vt) { const int v0 = 16 * vt + 4 * fq; const u32x2 og = ogv[vt]; const f32x4 gv = *(const f32x4*)(gm + v0);
            const float o0 = hsum[vt][0] * rstd * gv[0] * bflo(og.x), o1 = hsum[vt][1] * rstd * gv[1] * bfhi(og.x), o2 = hsum[vt][2] * rstd * gv[2] * bflo(og.y), o3 = hsum[vt][3] * rstd * gv[3] * bfhi(og.y);
            u32x2 o; o.x = pk2(o0, o1); o.y = pk2(o2, o3); if (dummy) *(u32x2*)((bf16_t*)a.out + (size_t)(tok0 + t) * 1024 + 128 * hd + v0) = o; else *(u32x2*)(orow + v0) = o; }
    }
    LDS_BAR();
}

constexpr int NA_VS = 80, NA_RPB = 512 * NA_VS, NA_HEAD = NA_RPB + 2176;
__device__ __forceinline__ void na_stage_rpb(const Args& a, LAS unsigned char* lds, int hp) {
    int tid_ = threadIdx.x; asm volatile("" : "+v"(tid_));
    const int hs = tid_ >> 8, ht = tid_ & 255, hd = 2 * hp + hs;
    LAS float* RPB = (LAS float*)(lds + hs * NA_HEAD + NA_RPB) + 32;
    const float v0 = a.in[12][hd * 465 + ht], v1 = (ht + 256 < 465) ? a.in[12][hd * 465 + ht + 256] : 0.f;
    RPB[ht] = v0 * 1.4426950408889634f; if (ht + 256 < 465) RPB[ht + 256] = v1 * 1.4426950408889634f;
    LDS_BAR();
}
__device__ __forceinline__ void na_group(const Args& a, LAS unsigned char* lds, int g) {
    int tid_ = threadIdx.x; asm volatile("" : "+v"(tid_));
    const int tid = tid_, lane = tid & 63, w = tid >> 6, hs = w >> 2, qt = w & 3, ht = tid & 255;
    const int hp = g & 3, b = (g >> 2) & 3, r0 = (g >> 4) * 8, hd = 2 * hp + hs;
    const char* Zb = (const char*)(a.ws + WS_Z);
    bf16_t* Z = (bf16_t*)(a.ws + WS_Z);
    LAS unsigned char* L = lds + hs * NA_HEAD;
    LAS float* RPB = (LAS float*)(L + NA_RPB) + 32;
    const int fr = lane & 15, fq = lane >> 4, q4 = (lane & 15) >> 2, p4 = lane & 3;
    const int c0 = 16 * qt, cb = qt == 0 ? 0 : (qt == 1 ? 8 : (qt == 2 ? 24 : 32));
    const int qcol = c0 + fr;
    const unsigned rowb = (unsigned)ZLD * 2u;
    const unsigned qoff = (unsigned)(b * SEQ + qcol) * rowb + (unsigned)(ZC_QNA + 32 * hd + 8 * fq) * 2u;
    const unsigned koff = (unsigned)(b * SEQ + cb + fr) * rowb + (unsigned)(ZC_KNA + 32 * hd + 8 * fq) * 2u;
    const int vcol = ht >> 2, vch = ht & 3;
    const unsigned voff = (unsigned)(b * SEQ + vcol) * rowb + (unsigned)(ZC_VNA + 32 * hd + 8 * vch) * 2u;
    const int cs = qcol < 8 ? 0 : (qcol - 8 > 48 ? 48 : qcol - 8);
    const int lv = cb + 4 * fq - cs;
    int rs = r0 < 4 ? 0 : (r0 - 4 > 120 ? 120 : r0 - 4);
    bf16x8 qf = *(const bf16x8*)(Zb + (qoff + (unsigned)(r0 * 64) * rowb));
    bf16x8 kf[16];
#pragma unroll
    for (int i = 0; i < 8; ++i)
#pragma unroll
        for (int hf = 0; hf < 2; ++hf) kf[i * 2 + hf] = *(const bf16x8*)(Zb + (koff + (unsigned)((rs + i) * 64 + 16 * hf) * rowb));
    {
        u32x4 v[8];
#pragma unroll
        for (int i = 0; i < 8; ++i) v[i] = *(const u32x4*)(Zb + (voff + (unsigned)((rs + i) * 64) * rowb));
#pragma unroll
        for (int i = 0; i < 8; ++i) *(LAS u32x4*)(L + ((((rs + i) & 7) * 64 + vcol) * NA_VS) + vch * 16) = v[i];
    }
#pragma unroll 1
    for (int rr = 0; rr < 8; ++rr) {
        const int r = r0 + rr;
        f32x4 sacc[16];
#pragma unroll
        for (int k = 0; k < 16; ++k) sacc[k] = mfma16(kf[k], qf, (f32x4){0.f, 0.f, 0.f, 0.f});
        LDS_BAR();
        const int rn = r + 1, rsn = rn < 4 ? 0 : (rn - 4 > 120 ? 120 : rn - 4);
        const bool more = rr < 7, slide = more && rsn != rs;
        bf16x8 qn = qf, kn0 = kf[14], kn1 = kf[15]; u32x4 vn = {0u, 0u, 0u, 0u};
        if (more) qn = *(const bf16x8*)(Zb + (qoff + (unsigned)(rn * 64) * rowb));
        if (slide) { kn0 = *(const bf16x8*)(Zb + (koff + (unsigned)((rsn + 7) * 64) * rowb)); kn1 = *(const bf16x8*)(Zb + (koff + (unsigned)((rsn + 7) * 64 + 16) * rowb));
            vn = *(const u32x4*)(Zb + (voff + (unsigned)((rsn + 7) * 64) * rowb)); }
        {
            const LAS float* bp = RPB + ((rs - r + 7) * 31 + (cb - c0 + 15) + 4 * fq - fr);
            const float NINF = -__builtin_inff();
            float mx = NINF;
#pragma unroll
            for (int i = 0; i < 8; ++i)
#pragma unroll
                for (int hf = 0; hf < 2; ++hf)
#pragma unroll
                    for (int j = 0; j < 4; ++j) { const bool valid = (unsigned)(lv + 16 * hf + j) < 16u;
                        const float sc = valid ? sacc[i * 2 + hf][j] + bp[31 * i + 16 * hf + j] : NINF;
                        sacc[i * 2 + hf][j] = sc; mx = fmaxf(mx, sc); }
            mx = quad_max(mx);
            float sum = 0.f;
#pragma unroll
            for (int k = 0; k < 16; ++k)
#pragma unroll
                for (int j = 0; j < 4; ++j) { const float e = __builtin_amdgcn_exp2f(sacc[k][j] - mx); sacc[k][j] = e; sum += e; }
            sum = quad_sum(sum);
            const float inv = __builtin_amdgcn_rcpf(sum);
            f32x4 o[2] = {{0.f, 0.f, 0.f, 0.f}, {0.f, 0.f, 0.f, 0.f}};
#pragma unroll
            for (int i = 0; i < 8; ++i) { float v8[8];
#pragma unroll
                for (int j = 0; j < 4; ++j) { v8[j] = sacc[2 * i][j]; v8[4 + j] = sacc[2 * i + 1][j]; }
                const bf16x8 pb = pack8(v8);
                const int slot = (rs + i) & 7;
#pragma unroll
                for (int dt = 0; dt < 2; ++dt) { LAS const unsigned char* pp = L + (slot * 64 + cb + 4 * fq + q4) * NA_VS + (16 * dt + 4 * p4) * 2;
                    o[dt] = mfma16(cat8(trrd(pp), trrd(pp + 16 * NA_VS)), pb, o[dt]); } }
            const size_t tokq = (size_t)b * SEQ + r * 64 + qcol;
#pragma unroll
            for (int dt = 0; dt < 2; ++dt) { u32x2 ov; ov.x = pk2(o[dt][0] * inv, o[dt][1] * inv); ov.y = pk2(o[dt][2] * inv, o[dt][3] * inv);
                *(u32x2*)(Z + tokq * ZLD + ZC_QNA + 32 * hd + 16 * dt + 4 * fq) = ov; }
        }
        LDS_BAR();
        if (slide) {
            *(LAS u32x4*)(L + ((((rsn + 7) & 7) * 64 + vcol) * NA_VS) + vch * 16) = vn;
#pragma unroll
            for (int k = 0; k < 14; ++k) kf[k] = kf[k + 2];
            kf[14] = kn0; kf[15] = kn1; rs = rsn;
        }
        qf = qn;
    }
}

constexpr int MA_S = 144, MA_K = 0, MA_V = 256 * MA_S;
__device__ __forceinline__ void memattn_unit(const Args& a, LAS unsigned char* lds, int unit, bool dummy = false) {
    int tid_ = threadIdx.x; asm volatile("" : "+v"(tid_));
    const int tid = tid_, lane = tid & 63, w = tid >> 6;
    const int tile = unit & 63, hd = (unit >> 6) & 3, b = unit >> 8;
    unsigned char* ws = a.ws;
    bf16_t* Z = (bf16_t*)(ws + WS_Z); const bf16_t* KV = (const bf16_t*)(ws + WS_KV);
#pragma unroll
    for (int i = 0; i < 4; ++i) { const int q = tid + 512 * i, m = q >> 3, ch = q & 7;
        const bf16_t* src = KV + (size_t)(b * 256 + m) * 512 + 64 * hd + 8 * ch;
        float v[8]; unpack8(*(const u32x4*)src, v); float ss = 0.f;
#pragma unroll
        for (int e = 0; e < 8; ++e) ss += v[e] * v[e];
        ss += __shfl_xor(ss, 1); ss += __shfl_xor(ss, 2); ss += __shfl_xor(ss, 4);
        const float rstd = rsqrtf(ss * (1.0f / 64.0f) + EPS);
        const f32x4 g0 = *(const f32x4*)(a.in[17] + 8 * ch), g1 = *(const f32x4*)(a.in[17] + 8 * ch + 4);
#pragma unroll
        for (int e = 0; e < 4; ++e) { v[e] *= rstd * g0[e]; v[4 + e] *= rstd * g1[e]; }
        *(LAS bf16x8*)(lds + MA_K + m * MA_S + ch * 16) = pack8(v);
        *(LAS u32x4*)(lds + MA_V + m * MA_S + ch * 16) = *(const u32x4*)(src + 256); }
    LDS_BAR();
    {
        const int fr = lane & 15, fq = lane >> 4, q4 = (lane & 15) >> 2, p4 = lane & 3;
        const size_t tok = (size_t)b * SEQ + tile * 128 + 16 * w + fr;
        bf16_t* qrow = Z + tok * ZLD + ZC_QMEM + 64 * hd;
        bf16x8 qf[2];
        { float v[16]; unpack8(*(const u32x4*)(qrow + 8 * fq), v); unpack8(*(const u32x4*)(qrow + 32 + 8 * fq), v + 8); float ss = 0.f;
#pragma unroll
            for (int e = 0; e < 16; ++e) ss += v[e] * v[e];
            ss = quad_sum(ss); const float rstd = rsqrtf(ss * (1.0f / 64.0f) + EPS) * 0.125f;
#pragma unroll
            for (int kk = 0; kk < 2; ++kk) { const f32x4 g0 = *(const f32x4*)(a.in[16] + 32 * kk + 8 * fq), g1 = *(const f32x4*)(a.in[16] + 32 * kk + 8 * fq + 4);
#pragma unroll
                for (int e = 0; e < 4; ++e) { v[8 * kk + e] *= rstd * g0[e]; v[8 * kk + 4 + e] *= rstd * g1[e]; }
                qf[kk] = pack8(v + 8 * kk); } }
        f32x4 sacc[16];
        float mx = -__builtin_inff();
#pragma unroll
        for (int kt = 0; kt < 16; ++kt) { f32x4 s = {0.f, 0.f, 0.f, 0.f};
#pragma unroll
            for (int kk = 0; kk < 2; ++kk) s = mfma16(*(LAS const bf16x8*)(lds + MA_K + (16 * kt + fr) * MA_S + (32 * kk + 8 * fq) * 2), qf[kk], s);
            sacc[kt] = s; mx = fmaxf(mx, fmaxf(fmaxf(s[0], s[1]), fmaxf(s[2], s[3]))); }
        mx = quad_max(mx);
        float sum = 0.f;
#pragma unroll
        for (int kt = 0; kt < 16; ++kt)
#pragma unroll
            for (int j = 0; j < 4; ++j) { const float e = __expf(sacc[kt][j] - mx); sacc[kt][j] = e; sum += e; }
        sum = quad_sum(sum);
        const float inv = __builtin_amdgcn_rcpf(sum);
        f32x4 o[4];
#pragma unroll
        for (int dt = 0; dt < 4; ++dt) o[dt] = (f32x4){0.f, 0.f, 0.f, 0.f};
#pragma unroll
        for (int ks = 0; ks < 8; ++ks) { float v8[8];
#pragma unroll
            for (int j = 0; j < 4; ++j) { v8[j] = sacc[2 * ks][j]; v8[4 + j] = sacc[2 * ks + 1][j]; }
            const bf16x8 pb = pack8(v8);
#pragma unroll
            for (int dt = 0; dt < 4; ++dt) { LAS const unsigned char* pp = lds + MA_V + (32 * ks + 4 * fq + q4) * MA_S + (16 * dt + 4 * p4) * 2;
                o[dt] = mfma16(cat8(trrd(pp), trrd(pp + 16 * MA_S)), pb, o[dt]); } }
#pragma unroll
        for (int dt = 0; dt < 4; ++dt) { u32x2 ov; ov.x = pk2(o[dt][0] * inv, o[dt][1] * inv); ov.y = pk2(o[dt][2] * inv, o[dt][3] * inv);
            if (dummy) *(u32x2*)((bf16_t*)a.out + tok * 1024 + 64 * hd + 16 * dt + 4 * fq) = ov; else *(u32x2*)(qrow + 16 * dt + 4 * fq) = ov; }
    }
    LDS_BAR();
}

#define XB_TMO      128
#define XB_XCNT(j)  (256  + 64 * (j))
#define XB_XSUB(j)  (1280 + 64 * (j))
#define XB_XGEN(j)  (2304 + 64 * (j))
#define XB_TOP      3328
#define XB_TOPGEN   3392
#define XCD_BAR_WORDS 3456
#define XB_SPIN_CAP (1u << 22)
__device__ __forceinline__ unsigned xb_ld(unsigned* p)              { return __hip_atomic_load(p, __ATOMIC_RELAXED, __HIP_MEMORY_SCOPE_AGENT); }
__device__ __forceinline__ unsigned xb_add(unsigned* p, unsigned v) { return __hip_atomic_fetch_add(p, v, __ATOMIC_RELAXED, __HIP_MEMORY_SCOPE_AGENT); }
__device__ __forceinline__ unsigned xb_xcc_id() { return (unsigned)__builtin_amdgcn_s_getreg((3 << 11) | 20) & 0xFu; }
#define XB_SPIN(cond, bar) do { unsigned _sp = 0; while (cond) { __builtin_amdgcn_s_sleep(1); \
    if ((++_sp & 255u) == 0u) { if (xb_ld(&(bar)[XB_TMO])) break; if (_sp > XB_SPIN_CAP) { atomicAdd(&(bar)[XB_TMO], 1u); break; } } } } while (0)
struct XcdBarrier { unsigned* bar; unsigned x; volatile LAS unsigned* st; };
__device__ __forceinline__ XcdBarrier xcd_barrier_post(unsigned* bar, volatile LAS unsigned* st) {
    XcdBarrier b; b.bar = bar; b.x = xb_xcc_id(); b.st = st;
    if (threadIdx.x == 0) (void)xb_add(&bar[XB_XCNT(b.x)], 1u);
    return b;
}
__device__ __forceinline__ void xcd_barrier_complete(unsigned* bar, unsigned x, unsigned& nloc, unsigned& nx) {
    const unsigned G = gridDim.x * gridDim.y * gridDim.z;
    unsigned sum, cnt, mine, sp = 0u;
    for (;;) {
        sum = 0u; cnt = 0u; mine = 0u;
#pragma unroll
        for (unsigned j = 0; j < 16; ++j) { const unsigned c = xb_ld(&bar[XB_XCNT(j)]); sum += c; cnt += (c > 0u) ? 1u : 0u; mine = (j == x) ? c : mine; }
        if (sum == G) break;
        __builtin_amdgcn_s_sleep(1);
        if ((++sp & 255u) == 0u) { if (xb_ld(&bar[XB_TMO])) break; if (sp > XB_SPIN_CAP) { atomicAdd(&bar[XB_TMO], 1u); break; } }
    }
    nloc = mine > 0u ? mine : 1u; nx = cnt > 0u ? cnt : 1u;
}
__device__ __forceinline__ void xcd_barrier(const XcdBarrier& b) {
    asm volatile("s_waitcnt vmcnt(0)" ::: "memory");
    __syncthreads();
    if (threadIdx.x == 0) {
        unsigned* bar = b.bar;
        __builtin_amdgcn_s_waitcnt(0);
        unsigned nloc = b.st[0], nx = b.st[1];
        if (nloc == 0u) { xcd_barrier_complete(bar, b.x, nloc, nx); b.st[0] = nloc; b.st[1] = nx; }
        const unsigned round = b.st[3]; b.st[3] = round + 1u;
        const unsigned old = xb_add(&bar[XB_XSUB(b.x)], 1u);
        if (old + 1u == (round + 1u) * nloc) {
            __builtin_amdgcn_fence(__ATOMIC_RELEASE, "agent");
            asm volatile("s_waitcnt vmcnt(0)" ::: "memory");
            (void)xb_add(&bar[XB_TOP], 1u);
        }
        const unsigned target = (round + 1u) * nx;
        XB_SPIN(xb_ld(&bar[XB_TOP]) < target, bar);
        __builtin_amdgcn_fence(__ATOMIC_ACQUIRE, "agent");
        asm volatile("s_waitcnt vmcnt(0)" ::: "memory");
    }
    __syncthreads();
}

__global__ void __launch_bounds__(512, 2) hybrid_fwd(Args a) {
    extern __shared__ __attribute__((aligned(16))) unsigned char lds_raw[];
    LAS unsigned char* lds = (LAS unsigned char*)lds_raw;
    cg::grid_group grid = cg::this_grid();
#ifdef USE_CG_SYNC
#define GRID_SYNC() do { asm volatile("s_waitcnt vmcnt(0) lgkmcnt(0)" ::: "memory"); grid.sync(); } while (0)
#else
    if (threadIdx.x < 4) ((volatile LAS unsigned*)(lds + LDS_BYTES - 64))[threadIdx.x] = 0u;
    __syncthreads();
    const XcdBarrier xbar = xcd_barrier_post((unsigned*)(a.ws + WS_BAR), (volatile LAS unsigned*)(lds + LDS_BYTES - 64));
    if (!grid.is_valid()) return;
#define GRID_SYNC() xcd_barrier(xbar)
#endif
    const int G = gridDim.x, bx = blockIdx.x;
    unsigned char* ws = a.ws;

#ifndef PH_MASK
#define PH_MASK 0x1ff
#endif
#ifndef REP0
#define REP0 1
#define REP1 1
#define REP2L 1
#define REP3 1
#define REP5 1
#endif
#ifndef REPNA
#define REPNA 1
#endif
#ifndef REPMO
#define REPMO 1
#endif
#ifndef REPMA
#define REPMA 1
#endif
    if (PH_MASK & 1) p0_prep(a, lds, G);
    if (REP0 > 1) { GRID_SYNC(); p0_prep(a, lds, G); }
    GRID_SYNC();
    if (PH_MASK & 2) {
        pg8::Gemm g{1024, 1024, 16, 128};
        pg8::Sched S; S.nM = T / 256; S.nN = NIN / 256; S.nwg = S.nM * S.nN; S.G = G; S.c = bx;
        S.A = (const char*)(ws + WS_H); S.B = (const char*)(ws + WS_WIN); S.tA = (size_t)256 * 1024 * 2; S.tB = (size_t)256 * 1024 * 2;
        S.nextra = 0; S.nN2 = 1; S.pnb2 = 0; S.A2 = S.A; S.B2 = S.B; S.tA2 = 0; S.tB2 = 0;
        pg8::EpiZ E{(bf16_t*)(ws + WS_Z), a.in[10], a.in[11]};
        pg8::gemm_phase<pg8::EpiZ, true>(lds, g, S, E);
        for (int u = bx; u < 128 + 64; u += G) { if (u < 128) gates_unit(a, u); else kv_unit(a, u - 128); }
    }
    if (REP1 > 1) { GRID_SYNC(); {
        pg8::Gemm g{1024, 1024, 16, 128};
        pg8::Sched S; S.nM = T / 256; S.nN = NIN / 256; S.nwg = S.nM * S.nN; S.G = G; S.c = bx;
        S.A = (const char*)(ws + WS_H); S.B = (const char*)(ws + WS_WIN); S.tA = (size_t)256 * 1024 * 2; S.tB = (size_t)256 * 1024 * 2;
        S.nextra = 0; S.nN2 = 1; S.pnb2 = 0; S.A2 = S.A; S.B2 = S.B; S.tA2 = 0; S.tB2 = 0;
        pg8::EpiZ E{(bf16_t*)(ws + WS_Z), a.in[10], a.in[11]};
        pg8::gemm_phase<pg8::EpiZ, true>(lds, g, S, E);
        for (int u = bx; u < 128 + 64; u += G) { if (u < 128) gates_unit(a, u); else kv_unit(a, u - 128); }
    } }
    GRID_SYNC();
#if defined(DBG_STOP) && DBG_STOP == 1
    { GRID_SYNC(); const bf16_t* Zb = (const bf16_t*)(ws + WS_Z); const float* gt = (const float*)(ws + WS_GATES); const bf16_t* kvb = (const bf16_t*)(ws + WS_KV);
      for (size_t i = (size_t)bx * 512 + threadIdx.x; i < (size_t)T * D; i += (size_t)G * 512) { const size_t t = i >> 10, j = i & 1023; float v = 0.f;
          for (int q = 0; q < 6; ++q) { const size_t col = j + 1024 * q; if (col < ZLD) v += bf2f(Zb[t * ZLD + col]); }
          v += gt[t * 16 + (j & 15)]; v += bf2f(kvb[(t & 1023) * 512 + (j & 511)]);
          a.out[i] = v; }
      return; }
#endif
#ifndef DBG_SUB
#define DBG_SUB 0
#endif
    if (PH_MASK & 4) {
        int u = bx;
        for (; u < 1024; u += G) { mlstm_local_unit(a, lds, u); if (REP2L > 1) mlstm_local_unit(a, lds, u); }
        { int last_hp = -1;
          for (int g = bx; g < 256; g += G) { const int hp = g & 3; if (hp != last_hp) { na_stage_rpb(a, lds, hp); last_hp = hp; } na_group(a, lds, g); } }
    }
    GRID_SYNC();
#if defined(DBG_STOP) && DBG_STOP == 2
    { GRID_SYNC(); const bf16_t* Zb = (const bf16_t*)(ws + WS_Z); const bf16_t* csb = (const bf16_t*)(ws + WS_H); const bf16_t* qk = (const bf16_t*)(ws + WS_QKC); const float* nsb = (const float*)(ws + WS_NS); const float* scb = (const float*)(ws + WS_SC);
      for (size_t i = (size_t)bx * 512 + threadIdx.x; i < (size_t)T * D; i += (size_t)G * 512) { const size_t t = i >> 10, j = i & 1023; float v;
#if DBG_SUB == 2
          v = bf2f(Zb[t * ZLD + ZC_QNA + (j & 255)]);
#elif DBG_SUB == 3
          v = bf2f(qk[t * 512 + (j & 511)]);
#elif DBG_SUB == 4
          v = (j < 1020) ? bf2f(csb[i]) : 0.f;
#elif DBG_SUB == 5
          v = (j < 512) ? nsb[(i >> 2) & 262143] : scb[(i >> 1) & 8191];
#else
          if (j < 256) v = 0.f; else if (j < 768) v = bf2f(qk[t * 512 + (j - 256)]); else if (j < 1020) v = bf2f(csb[i]); else if (j < 1022) v = nsb[(i >> 2) & 262143]; else v = scb[(i >> 1) & 8191];
#endif
          a.out[i] = v; }
      return; }
#endif
#ifdef XSYNC
    for (int q = 0; q < XSYNC; ++q) GRID_SYNC();
#endif
    if (PH_MASK & 8) mlstm_scan(a, G);
    GRID_SYNC();
    if (PH_MASK & 16) for (int u = bx; u < 2048; u += G) { if (u < 1024) { if (REPMO > 1) mlstm_out_unit(a, lds, u, true); mlstm_out_unit(a, lds, u); } else { if (REPMA > 1) memattn_unit(a, lds, u - 1024, true); memattn_unit(a, lds, u - 1024); } }
    GRID_SYNC();
#if defined(DBG_STOP) && DBG_STOP == 4
    { GRID_SYNC(); const bf16_t* Zb = (const bf16_t*)(ws + WS_Z);
      for (size_t i = (size_t)bx * 512 + threadIdx.x; i < (size_t)T * D; i += (size_t)G * 512) { const size_t t = i >> 10, j = i & 1023;
          a.out[i] = bf2f(Zb[t * ZLD + 1024 + j]); }
      return; }
#endif
    if (PH_MASK & 32) {
        pg8::Gemm g{ZLD, 1024, 16, 128};
        pg8::Sched S; S.nM = T / 256; S.nN = 4; S.nwg = S.nM * S.nN; S.G = G; S.c = bx;
        S.A = (const char*)(ws + WS_Z) + ZC_O * 2; S.B = (const char*)(ws + WS_WCAT); S.tA = (size_t)256 * ZLD * 2; S.tB = (size_t)256 * 1024 * 2;
        S.nextra = 0; S.nN2 = 1; S.pnb2 = 0; S.A2 = S.A; S.B2 = S.B; S.tA2 = 0; S.tB2 = 0;
        pg8::EpiMerge E{(const bf16_t*)(ws + WS_Z), (bf16_t*)(ws + WS_H)};
        pg8::gemm_phase<pg8::EpiMerge, true>(lds, g, S, E);
    }
    if (REP3 > 1) { GRID_SYNC(); {
        pg8::Gemm g{ZLD, 1024, 16, 128};
        pg8::Sched S; S.nM = T / 256; S.nN = 4; S.nwg = S.nM * S.nN; S.G = G; S.c = bx;
        S.A = (const char*)(ws + WS_Z) + ZC_O * 2; S.B = (const char*)(ws + WS_WCAT); S.tA = (size_t)256 * ZLD * 2; S.tB = (size_t)256 * 1024 * 2;
        S.nextra = 0; S.nN2 = 1; S.pnb2 = 0; S.A2 = S.A; S.B2 = S.B; S.tA2 = 0; S.tB2 = 0;
        pg8::EpiMerge E{(const bf16_t*)(ws + WS_Z), (bf16_t*)(ws + WS_H)};
        pg8::gemm_phase<pg8::EpiMerge, true>(lds, g, S, E);
    } }
    GRID_SYNC();
    if (PH_MASK & 64) {
        pg8::Gemm g{1024, 1024, 16, 128};
        pg8::Sched S; S.nM = T / 256; S.nN = 4; S.nwg = S.nM * S.nN; S.G = G; S.c = bx;
        S.A = (const char*)(ws + WS_H); S.B = (const char*)(ws + WS_WOUT); S.tA = (size_t)256 * 1024 * 2; S.tB = (size_t)256 * 1024 * 2;
        S.nextra = 0; S.nN2 = 1; S.pnb2 = 0; S.A2 = S.A; S.B2 = S.B; S.tA2 = 0; S.tB2 = 0;
        pg8::EpiX1 E{a.in[0], a.out, (bf16_t*)(ws + WS_X1B), (float*)(ws + WS_SUMSQ)};
        pg8::gemm_phase<pg8::EpiX1, true>(lds, g, S, E);
    }
    GRID_SYNC();
    if (PH_MASK & 128) {
        pg8::Gemm g{1024, 1024, 16, 128};
        pg8::Sched S; S.nM = T / 256; S.nN = FF / 256; S.nwg = S.nM * S.nN; S.G = G; S.c = bx;
        S.A = (const char*)(ws + WS_X1B); S.B = (const char*)(ws + WS_WUP); S.tA = (size_t)256 * 1024 * 2; S.tB = (size_t)256 * 1024 * 2;
        S.nextra = 0; S.nN2 = 1; S.pnb2 = 0; S.A2 = S.A; S.B2 = S.B; S.tA2 = 0; S.tB2 = 0;
        pg8::EpiUp E{(const float*)(ws + WS_SUMSQ), (bf16_t*)(ws + WS_U)};
        pg8::gemm_phase<pg8::EpiUp, true>(lds, g, S, E);
    }
    if (REP5 > 1) { GRID_SYNC(); {
        pg8::Gemm g{1024, 1024, 16, 128};
        pg8::Sched S; S.nM = T / 256; S.nN = FF / 256; S.nwg = S.nM * S.nN; S.G = G; S.c = bx;
        S.A = (const char*)(ws + WS_X1B); S.B = (const char*)(ws + WS_WUP); S.tA = (size_t)256 * 1024 * 2; S.tB = (size_t)256 * 1024 * 2;
        S.nextra = 0; S.nN2 = 1; S.pnb2 = 0; S.A2 = S.A; S.B2 = S.B; S.tA2 = 0; S.tB2 = 0;
        pg8::EpiUp E{(const float*)(ws + WS_SUMSQ), (bf16_t*)(ws + WS_U)};
        pg8::gemm_phase<pg8::EpiUp, true>(lds, g, S, E);
    } }
    GRID_SYNC();
    if (PH_MASK & 256) {
        pg8::Gemm g{64, FF, 64, 32768};
        pg8::Sched S; S.nM = T / 256; S.nN = 4; S.nwg = S.nM * S.nN; S.G = G; S.c = bx;
        S.A = (const char*)(ws + WS_U); S.B = (const char*)(ws + WS_WDOWN); S.tA = (size_t)256 * FF * 2; S.tB = (size_t)256 * FF * 2;
        S.nextra = 0; S.nN2 = 1; S.pnb2 = 0; S.A2 = S.A; S.B2 = S.B; S.tA2 = 0; S.tB2 = 0;
        pg8::EpiDown E{a.out, (const bf16_t*)(ws + WS_X1B)};
        pg8::gemm_phase<pg8::EpiDown, true>(lds, g, S, E);
    }
}

extern "C" void kernel_launch(void* const* d_in, const int* in_sizes, int n_in, void* d_out, int out_size, void* d_ws, size_t ws_size, hipStream_t stream) {
    static int grid = 0;
    if (grid == 0) {
        if (n_in != 23 || out_size != T * D || ws_size < WS_END) { fprintf(stderr, "kernel_launch: unexpected shapes (n_in %d out %d ws %zu)\n", n_in, out_size, ws_size); grid = -1; return; }
        int dev = 0, cus = 0, per_cu = 0;
        hipGetDevice(&dev);
        hipDeviceGetAttribute(&cus, hipDeviceAttributeMultiprocessorCount, dev);
        hipFuncSetAttribute((const void*)hybrid_fwd, hipFuncAttributeMaxDynamicSharedMemorySize, LDS_BYTES);
        hipOccupancyMaxActiveBlocksPerMultiprocessor(&per_cu, (const void*)hybrid_fwd, 512, LDS_BYTES);
        if (per_cu < 1) per_cu = 1;
        grid = cus * per_cu;
        (void)hipGetLastError();
    }
    if (grid < 0) return;
    if (hipMemsetAsync((char*)d_ws + WS_BAR, 0, 16384, stream) != hipSuccess) { fprintf(stderr, "kernel_launch: memset of the barrier words failed\n"); return; }
    Args a{};
    for (int i = 0; i < 23; ++i) a.in[i] = (const float*)d_in[i];
    a.out = (float*)d_out; a.ws = (unsigned char*)d_ws;
    void* args[] = {&a};
    hipError_t e = hipLaunchCooperativeKernel((const void*)hybrid_fwd, dim3(grid), dim3(512), args, LDS_BYTES, stream);
    if (e != hipSuccess) fprintf(stderr, "cooperative launch failed: %s (grid %d)\n", hipGetErrorString(e), grid);
}
```

```cpp
#include <hip/hip_runtime.h>
#include <hip/hip_cooperative_groups.h>
#include <cstdio>
#include <cstdint>
namespace cg = cooperative_groups;

#define LAS __attribute__((address_space(3)))
typedef unsigned short bf16_t;
typedef short bf16x8 __attribute__((ext_vector_type(8)));
typedef short s16x4 __attribute__((ext_vector_type(4)));
typedef short v4i16_t __attribute__((ext_vector_type(4)));
typedef float f32x4 __attribute__((ext_vector_type(4)));
typedef float f32x2 __attribute__((ext_vector_type(2)));
typedef unsigned u32x4 __attribute__((ext_vector_type(4)));
typedef unsigned u32x2 __attribute__((ext_vector_type(2)));

constexpr int NB = 4, SEQ = 8192, T = NB * SEQ, D = 1024, FF = 4096, DIN = 5648;
constexpr int ZLD = 5632;
constexpr int ZC_QK = 0, ZC_V = 512, ZC_O = 1024, ZC_QNA = 1536, ZC_QMEM = 1792, ZC_KNA = 2048, ZC_VNA = 2304, ZC_GATE = 2560;
constexpr int NIN = 5632;
constexpr float EPS = 1e-6f;
constexpr size_t MiB = 1u << 20;
constexpr size_t WS_SUMSQ = 0;
constexpr size_t WS_BAR = 512 * 1024;
constexpr size_t WS_GATES = 1 * MiB;
constexpr size_t WS_SC = 3 * MiB;
constexpr size_t WS_MS = 3 * MiB + 65536;
constexpr size_t WS_NS = 4 * MiB;
constexpr size_t WS_MEMN = 5 * MiB;
constexpr size_t WS_KV = 7 * MiB;
constexpr size_t WS_WIN = 8 * MiB;
constexpr size_t WS_WCAT = 20 * MiB;
constexpr size_t WS_WOUT = 22 * MiB;
constexpr size_t WS_WUP = 24 * MiB;
constexpr size_t WS_WDOWN = 32 * MiB;
constexpr size_t WS_WKV = 40 * MiB;
constexpr size_t WS_Z = 42 * MiB;
constexpr size_t WS_U = 42 * MiB;
constexpr size_t WS_X1B = 298 * MiB;
constexpr size_t WS_H = 394 * MiB;
constexpr size_t WS_QKC = 458 * MiB;
constexpr size_t WS_END = 490 * MiB;
constexpr int LDS_BYTES = 147456;

__device__ __forceinline__ float bf2f(unsigned short b) { return __uint_as_float((unsigned)b << 16); }
__device__ __forceinline__ float bflo(unsigned w) { return __uint_as_float(w << 16); }
__device__ __forceinline__ float bfhi(unsigned w) { return __uint_as_float(w & 0xffff0000u); }
typedef __bf16 bf16x2_t __attribute__((ext_vector_type(2)));
__device__ __forceinline__ unsigned pk2(float lo, float hi) { const f32x2 v = {lo, hi}; const bf16x2_t b = __builtin_convertvector(v, bf16x2_t); return __builtin_bit_cast(unsigned, b); }
__device__ __forceinline__ float wave_sum(float v) {
#pragma unroll
    for (int o = 1; o < 64; o <<= 1) v += __shfl_xor(v, o);
    return v;
}
__device__ __forceinline__ float wave_max(float v) {
#pragma unroll
    for (int o = 1; o < 64; o <<= 1) v = fmaxf(v, __shfl_xor(v, o));
    return v;
}
__device__ __forceinline__ float quad_sum(float v) { v += __shfl_xor(v, 16); v += __shfl_xor(v, 32); return v; }
__device__ __forceinline__ float quad_max(float v) { v = fmaxf(v, __shfl_xor(v, 16)); v = fmaxf(v, __shfl_xor(v, 32)); return v; }
__device__ __forceinline__ s16x4 trrd(LAS const unsigned char* p) { return __builtin_amdgcn_ds_read_tr16_b64_v4i16((LAS v4i16_t*)p); }
__device__ __forceinline__ bf16x8 cat8(s16x4 a, s16x4 b) { return (bf16x8){a[0], a[1], a[2], a[3], b[0], b[1], b[2], b[3]}; }
__device__ __forceinline__ bf16x8 pack8(const float* v) {
    u32x4 w; w.x = pk2(v[0], v[1]); w.y = pk2(v[2], v[3]); w.z = pk2(v[4], v[5]); w.w = pk2(v[6], v[7]);
    return __builtin_bit_cast(bf16x8, w);
}
__device__ __forceinline__ void unpack8(u32x4 w, float* v) {
    v[0] = bflo(w.x); v[1] = bfhi(w.x); v[2] = bflo(w.y); v[3] = bfhi(w.y); v[4] = bflo(w.z); v[5] = bfhi(w.z); v[6] = bflo(w.w); v[7] = bfhi(w.w);
}
__device__ __forceinline__ f32x4 mfma16(bf16x8 a, bf16x8 b, f32x4 c) { return __builtin_amdgcn_mfma_f32_16x16x32_bf16(a, b, c, 0, 0, 0); }
__device__ __forceinline__ float sigmoidf_(float x) { return __builtin_amdgcn_rcpf(1.0f + __expf(-x)); }
#define LDS_WAIT() asm volatile("s_waitcnt lgkmcnt(0)" ::: "memory")
#define LDS_BAR() do { asm volatile("s_waitcnt lgkmcnt(0)" ::: "memory"); __builtin_amdgcn_s_barrier(); asm volatile("" ::: "memory"); } while (0)

struct Args {
    const float* in[23]; float* out; unsigned char* ws;
};

namespace pg8 {
constexpr int BM = 256, BK = 64, HALF = 128, HTB = HALF * BK * 2, STAGE_BYTES = 8 * HTB, NXCD = 8, WGM = 4;
__device__ __forceinline__ int lds_byte(int r, int c) { const int st = (r >> 4) * 2 + (c >> 5), rr = r & 15, cc = c & 31, ob = rr * 64 + cc * 2; return st * 1024 + (ob ^ (((ob >> 9) & 1) << 5)); }
__device__ __forceinline__ void stage_rc(int b, int& R, int& C) { const int st = b / 1024, sb = b % 1024, swz = sb ^ (((sb >> 9) & 1) << 5); R = (st >> 1) * 16 + swz / 64; C = (st & 1) * 32 + (swz % 64) / 2; }
__device__ __forceinline__ int perm32(int rho) { const int n = rho >> 4, i = rho & 15; return 8 * (i >> 2) + 4 * n + (i & 3); }

struct Unit { int pm, pn; const char* A; const char* B; };
struct Gemm { int lda, ldb, nt, kstepA; };

struct Sched {
    int nM, nN, nwg, G, c; const char* A; const char* B; size_t tA, tB;
    int nextra, nN2, pnb2; const char* A2; const char* B2; size_t tA2, tB2;
    __device__ __forceinline__ bool next(int i, Unit& u) const {
        const long L = (long)i * G + c;
        if (L >= nwg) {
            const long j = L - nwg; if (j >= nextra) return false;
            const int pm = (int)(j / nN2), pn = (int)(j % nN2);
            u.pm = pm; u.pn = pnb2 + pn; u.A = A2 + (size_t)pm * tA2; u.B = B2 + (size_t)pn * tB2; return true;
        }
        int wgid = (int)L; { const int q = nwg / NXCD, r = nwg % NXCD, xcd = wgid % NXCD, off = wgid / NXCD; wgid = (xcd < r ? xcd * (q + 1) : r * (q + 1) + (xcd - r) * q) + off; }
        const int nig = WGM * nN, gid = wgid / nig, fm = gid * WGM, gsz = (nM - fm) < WGM ? (nM - fm) : WGM;
        u.pm = fm + ((wgid % nig) % gsz); u.pn = (wgid % nig) / gsz;
        u.A = A + (size_t)u.pm * tA; u.B = B + (size_t)u.pn * tB; return true;
    }
};

template <class Epi, bool ALIGN_EPI>
__device__ __forceinline__ void gemm_phase(LAS unsigned char* lds, const Gemm g, const Sched& S, const Epi& E) {
    int tid_ = threadIdx.x; asm volatile("" : "+v"(tid_));
    const int tid = tid_, wid = __builtin_amdgcn_readfirstlane(tid >> 6), lane = tid & 63, wr = wid >> 2, wc = wid & 3, fr = lane & 15, fq = lane >> 4;
    const int nt = g.nt;
    unsigned voffA[2], voffB[2];
#pragma unroll
    for (int i = 0; i < 2; ++i) { int R, C; stage_rc(tid * 16 + i * 8192, R, C); const int Rb = (R & ~31) + perm32(R & 31);
        voffA[i] = (unsigned)(R * g.lda + C) * 2u; voffB[i] = (unsigned)(Rb * g.ldb + C) * 2u; }
    const size_t kstep = (size_t)(BK * 2), kstepA = (size_t)g.kstepA;
    const size_t hstepA = (size_t)HALF * g.lda * 2, hstepB = (size_t)HALF * g.ldb * 2;
    const unsigned ldsw = (unsigned)wid * 1024u;
    const int aoff = lds_byte(wr * 64 + fr, fq * 8), boff = lds_byte(wc * 32 + fr, fq * 8);
#define PG8_SA(b, h) (((b) * 2 + (h)) * HTB)
#define PG8_SB(b, h) ((4 + (b) * 2 + (h)) * HTB)
#define PG8_STAGE(bufoff, gbase, voff) do { _Pragma("unroll") for (int _i = 0; _i < 2; ++_i) \
        __builtin_amdgcn_global_load_lds((const unsigned*)((const char*)(gbase) + (voff)[_i]), (LAS unsigned*)(lds + (bufoff) + ldsw + _i * 8192), 16, 0, 0); } while (0)
#define PG8_LDA(dst, b, h) do { _Pragma("unroll") for (int m = 0; m < 4; ++m) _Pragma("unroll") for (int k = 0; k < 2; ++k) dst[m][k] = *(const LAS bf16x8*)(lds + PG8_SA(b, h) + aoff + m * 2048 + k * 1024); } while (0)
#define PG8_LDB(dst, b, h) do { _Pragma("unroll") for (int n = 0; n < 2; ++n) _Pragma("unroll") for (int k = 0; k < 2; ++k) dst[n][k] = *(const LAS bf16x8*)(lds + PG8_SB(b, h) + boff + n * 2048 + k * 1024); } while (0)
#define PG8_MMA(ai, bj, At, Bt) do { __builtin_amdgcn_s_setprio(3); _Pragma("unroll") for (int m = 0; m < 4; ++m) _Pragma("unroll") for (int n = 0; n < 2; ++n) _Pragma("unroll") for (int k = 0; k < 2; ++k) \
        acc[ai][bj][m][n] = __builtin_amdgcn_mfma_f32_16x16x32_bf16(Bt[n][k], At[m][k], acc[ai][bj][m][n], 0, 0, 0); __builtin_amdgcn_s_setprio(0); } while (0)
#define PG8_WAIT_V(n) asm volatile("s_waitcnt vmcnt(" #n ")" ::: "memory")
#define PG8_WAIT_L(n) asm volatile("s_waitcnt lgkmcnt(" #n ")" ::: "memory")
#define PG8_BAR __builtin_amdgcn_s_barrier()
#define PG8_SCHED __builtin_amdgcn_sched_barrier(0)
    Unit cur, nxt; int ui = 0;
    if (!S.next(0, cur)) return;
    f32x4 acc[2][2][4][2];
#pragma unroll
    for (int a = 0; a < 2; ++a)
#pragma unroll
        for (int b = 0; b < 2; ++b)
#pragma unroll
            for (int m = 0; m < 4; ++m)
#pragma unroll
                for (int n = 0; n < 2; ++n) acc[a][b][m][n] = (f32x4){0.f, 0.f, 0.f, 0.f};
    bf16x8 At[4][2], B0[2][2], B1[2][2];
    const char* cA = cur.A; const char* cB = cur.B;
    PG8_STAGE(PG8_SB(0, 0), cB, voffB); PG8_STAGE(PG8_SB(0, 1), cB + hstepB, voffB); PG8_STAGE(PG8_SA(0, 0), cA, voffA); PG8_STAGE(PG8_SA(0, 1), cA + hstepA, voffA);
    if (wr == 1) PG8_BAR;
    PG8_WAIT_V(2); PG8_BAR;
    PG8_STAGE(PG8_SB(1, 0), cB + kstep, voffB); PG8_STAGE(PG8_SA(1, 0), cA + kstepA, voffA); PG8_STAGE(PG8_SB(1, 1), cB + hstepB + kstep, voffB);
    PG8_WAIT_V(6); PG8_BAR;
    for (;;) {
        const bool has_next = S.next(ui + 1, nxt);
        const char* nA = has_next ? nxt.A : cA; const char* nB = has_next ? nxt.B : cB;
        for (int t = 0; t < nt; t += 2) {
            const bool last = (t == nt - 2);
            const char* a1 = cA + (size_t)(t + 1) * kstepA;
            const char* a2 = last ? nA : cA + (size_t)(t + 2) * kstepA; const char* b2 = last ? nB : cB + (size_t)(t + 2) * kstep;
            const char* a3 = a2 + kstepA; const char* b3 = b2 + kstep;
            PG8_LDB(B0, 0, 0); PG8_LDB(B1, 0, 1); PG8_SCHED; PG8_LDA(At, 0, 0); PG8_STAGE(PG8_SA(1, 1), a1 + hstepA, voffA);
            PG8_WAIT_V(8); PG8_WAIT_L(0); PG8_BAR; PG8_MMA(0, 0, At, B0); PG8_MMA(0, 1, At, B1); PG8_BAR; PG8_SCHED;
            PG8_LDA(At, 0, 1); PG8_STAGE(PG8_SB(0, 0), b2, voffB); PG8_STAGE(PG8_SB(0, 1), b2 + hstepB, voffB); PG8_STAGE(PG8_SA(0, 0), a2, voffA);
            PG8_WAIT_V(8); PG8_WAIT_L(0); PG8_BAR; PG8_MMA(1, 0, At, B0); PG8_MMA(1, 1, At, B1); PG8_BAR; PG8_SCHED;
            PG8_LDB(B0, 1, 0); PG8_LDB(B1, 1, 1); PG8_SCHED; PG8_LDA(At, 1, 0); PG8_STAGE(PG8_SA(0, 1), a2 + hstepA, voffA);
            PG8_WAIT_V(8); PG8_WAIT_L(0); PG8_BAR; PG8_MMA(0, 0, At, B0); PG8_MMA(0, 1, At, B1); PG8_BAR; PG8_SCHED;
            PG8_LDA(At, 1, 1); PG8_STAGE(PG8_SB(1, 0), b3, voffB); PG8_STAGE(PG8_SB(1, 1), b3 + hstepB, voffB); PG8_STAGE(PG8_SA(1, 0), a3, voffA);
            PG8_WAIT_V(8); PG8_WAIT_L(0); PG8_BAR; PG8_MMA(1, 0, At, B0); PG8_MMA(1, 1, At, B1); PG8_BAR; PG8_SCHED;
            if constexpr (Epi::MID) { if (t + 2 == 8 || t + 2 == 12) { E.mid(acc, cur, (t + 2 == 8) ? 0 : 1, wr, wc, fr, fq); PG8_SCHED; } }
        }
        if constexpr (ALIGN_EPI) { if (wr == 0) PG8_BAR; }
        E(acc, cur, wr, wc, fr, fq);
        if (!has_next) break;
#pragma unroll
        for (int a = 0; a < 2; ++a)
#pragma unroll
            for (int b = 0; b < 2; ++b)
#pragma unroll
                for (int m = 0; m < 4; ++m)
#pragma unroll
                    for (int n = 0; n < 2; ++n) acc[a][b][m][n] = (f32x4){0.f, 0.f, 0.f, 0.f};
        cur = nxt; cA = nA; cB = nB; ++ui;
        if constexpr (ALIGN_EPI) { if (wr == 1) PG8_BAR; }
    }
    PG8_WAIT_V(0);
    if constexpr (!ALIGN_EPI) { if (wr == 0) PG8_BAR; }
    PG8_BAR;
#undef PG8_SA
#undef PG8_SB
#undef PG8_STAGE
#undef PG8_LDA
#undef PG8_LDB
#undef PG8_MMA
#undef PG8_WAIT_V
#undef PG8_WAIT_L
#undef PG8_BAR
#undef PG8_SCHED
}

__device__ __forceinline__ u32x4 pk8(f32x4 v0, f32x4 v1) { u32x4 w; w.x = pk2(v0[0], v0[1]); w.y = pk2(v0[2], v0[3]); w.z = pk2(v1[0], v1[1]); w.w = pk2(v1[2], v1[3]); return w; }
__device__ __forceinline__ f32x4 sig4(f32x4 v) { f32x4 o; o[0] = sigmoidf_(v[0]); o[1] = sigmoidf_(v[1]); o[2] = sigmoidf_(v[2]); o[3] = sigmoidf_(v[3]); return o; }

struct EpiZ {
    static constexpr bool MID = false;
    bf16_t* Z; const float* gq; const float* gk;
    __device__ __forceinline__ void operator()(const f32x4 (&acc)[2][2][4][2], const Unit& u, int wr, int wc, int fr, int fq) const {
        const int row0 = u.pm * BM + wr * 64 + fr;
        const int col0 = u.pn * BM + wc * 32 + 8 * fq;
        if (u.pn == 6 || u.pn == 8) {
            const float* g = (u.pn == 6) ? gq : gk; const float sc = (u.pn == 6) ? 0.17677669529663687f * 1.4426950408889634f : 1.0f;
            const f32x4 g0 = *(const f32x4*)(g + 8 * fq) * sc, g1 = *(const f32x4*)(g + 8 * fq + 4) * sc;
#pragma unroll
            for (int ai = 0; ai < 2; ++ai)
#pragma unroll
                for (int m = 0; m < 4; ++m) { bf16_t* rowp = Z + (size_t)(row0 + ai * HALF + m * 16) * ZLD + col0;
#pragma unroll
                    for (int bj = 0; bj < 2; ++bj) { f32x4 v0 = acc[ai][bj][m][0], v1 = acc[ai][bj][m][1];
                        float ss = (v0[0] * v0[0] + v0[1] * v0[1]) + (v0[2] * v0[2] + v0[3] * v0[3]) + (v1[0] * v1[0] + v1[1] * v1[1]) + (v1[2] * v1[2] + v1[3] * v1[3]);
                        ss = quad_sum(ss); const float rstd = rsqrtf(ss * (1.0f / 32.0f) + EPS);
                        v0 = v0 * rstd * g0; v1 = v1 * rstd * g1;
                        __builtin_nontemporal_store(pk8(v0, v1), (u32x4*)(rowp + bj * HALF)); } }
            return;
        }
        const bool sg = (u.pn == 4 || u.pn == 5 || u.pn >= 10);
#pragma unroll
        for (int ai = 0; ai < 2; ++ai)
#pragma unroll
            for (int m = 0; m < 4; ++m) { bf16_t* rowp = Z + (size_t)(row0 + ai * HALF + m * 16) * ZLD + col0;
#pragma unroll
                for (int bj = 0; bj < 2; ++bj) { f32x4 v0 = acc[ai][bj][m][0], v1 = acc[ai][bj][m][1];
                    if (sg) { v0 = sig4(v0); v1 = sig4(v1); }
                    __builtin_nontemporal_store(pk8(v0, v1), (u32x4*)(rowp + bj * HALF)); } }
    }
};

#ifndef HOOK_MB
#define HOOK_MB 4
#endif
struct EpiMerge {
    static constexpr bool MID = true;
    const bf16_t* Z; bf16_t* Y;
    __device__ __forceinline__ void mid(f32x4 (&acc)[2][2][4][2], const Unit& u, int which, int wr, int wc, int fr, int fq) const {
        int row0 = u.pm * BM + wr * 64 + fr; const int col0 = u.pn * BM + wc * 32 + 8 * fq;
        asm volatile("" : "+v"(row0));
        const bf16_t* gp0 = Z + (size_t)row0 * ZLD + ZC_GATE + which * 1024 + col0;
#pragma unroll
        for (int ai = 0; ai < 2; ++ai)
#pragma unroll
            for (int m0 = 0; m0 < 4; m0 += HOOK_MB) {
                u32x4 ga[HOOK_MB][2], gb[HOOK_MB][2];
#pragma unroll
                for (int mm = 0; mm < HOOK_MB; ++mm) { const bf16_t* gp = gp0 + (size_t)(ai * HALF + (m0 + mm) * 16) * ZLD;
#pragma unroll
                    for (int bj = 0; bj < 2; ++bj) { ga[mm][bj] = *(const u32x4*)(gp + bj * HALF); gb[mm][bj] = *(const u32x4*)(gp + 1024 + bj * HALF); } }
#pragma unroll
                for (int mm = 0; mm < HOOK_MB; ++mm)
#pragma unroll
                    for (int bj = 0; bj < 2; ++bj) { float a[8], b[8]; unpack8(ga[mm][bj], a); unpack8(gb[mm][bj], b);
#pragma unroll
                        for (int e = 0; e < 8; ++e) { const float r = a[e] * __builtin_amdgcn_rcpf(fmaxf(b[e], 1e-30f)); acc[ai][bj][m0 + mm][e >> 2][e & 3] *= r; } }
                asm volatile("" ::: "memory"); }
    }
    __device__ __forceinline__ void operator()(const f32x4 (&acc)[2][2][4][2], const Unit& u, int wr, int wc, int fr, int fq) const {
        const int row0 = u.pm * BM + wr * 64 + fr, col0 = u.pn * BM + wc * 32 + 8 * fq;
#pragma unroll
        for (int ai = 0; ai < 2; ++ai)
#pragma unroll
            for (int m = 0; m < 4; ++m) { const size_t r = (size_t)(row0 + ai * HALF + m * 16);
#pragma unroll
                for (int bj = 0; bj < 2; ++bj) { const u32x4 gc = *(const u32x4*)(Z + r * ZLD + ZC_GATE + 2048 + col0 + bj * HALF);
                    float c[8]; unpack8(gc, c); f32x4 v0 = acc[ai][bj][m][0], v1 = acc[ai][bj][m][1];
#pragma unroll
                    for (int e = 0; e < 4; ++e) { v0[e] *= fmaxf(c[e], 1e-30f); v1[e] *= fmaxf(c[4 + e], 1e-30f); }
                    *(u32x4*)(Y + r * D + col0 + bj * HALF) = pk8(v0, v1); } }
    }
};

struct EpiX1 {
    static constexpr bool MID = false;
    const float* x; float* out; bf16_t* x1b; float* sumsq;
    __device__ __forceinline__ void operator()(const f32x4 (&acc)[2][2][4][2], const Unit& u, int wr, int wc, int fr, int fq) const {
        const int row0 = u.pm * BM + wr * 64 + fr, col0 = u.pn * BM + wc * 32 + 8 * fq;
#pragma unroll
        for (int ai = 0; ai < 2; ++ai)
#pragma unroll
            for (int m = 0; m < 4; ++m) { const size_t r = (size_t)(row0 + ai * HALF + m * 16); float ss = 0.f;
#pragma unroll
                for (int bj = 0; bj < 2; ++bj) { const size_t o = r * D + col0 + bj * HALF;
                    const f32x4 v0 = *(const f32x4*)(x + o) + acc[ai][bj][m][0], v1 = *(const f32x4*)(x + o + 4) + acc[ai][bj][m][1];
                    *(u32x4*)(x1b + o) = pk8(v0, v1);
                    ss += (v0[0] * v0[0] + v0[1] * v0[1]) + (v0[2] * v0[2] + v0[3] * v0[3]) + (v1[0] * v1[0] + v1[1] * v1[1]) + (v1[2] * v1[2] + v1[3] * v1[3]); }
                ss = quad_sum(ss);
                if (fq == 0) atomicAdd(sumsq + r, ss); }
    }
};

struct EpiUp {
    static constexpr bool MID = false;
    const float* sumsq; bf16_t* U;
    __device__ __forceinline__ void operator()(const f32x4 (&acc)[2][2][4][2], const Unit& u, int wr, int wc, int fr, int fq) const {
        const int row0 = u.pm * BM + wr * 64 + fr, col0 = u.pn * BM + wc * 32 + 8 * fq;
#pragma unroll
        for (int ai = 0; ai < 2; ++ai)
#pragma unroll
            for (int m = 0; m < 4; ++m) { const size_t r = (size_t)(row0 + ai * HALF + m * 16); const float rstd = rsqrtf(sumsq[r] * (1.0f / D) + EPS);
#pragma unroll
                for (int bj = 0; bj < 2; ++bj) { f32x4 v0 = acc[ai][bj][m][0] * rstd, v1 = acc[ai][bj][m][1] * rstd;
#pragma unroll
                    for (int e = 0; e < 4; ++e) { const float a = fmaxf(v0[e], 0.f), b = fmaxf(v1[e], 0.f); v0[e] = a * a; v1[e] = b * b; }
                    const int colt = wc * 32 + 8 * fq + bj * HALF, kt = u.pn * 4 + (colt >> 6), rin = (int)(r - (size_t)u.pm * BM);
                    __builtin_nontemporal_store(pk8(v0, v1), (u32x4*)(U + ((size_t)(u.pm * 64 + kt) * 256 + rin) * 64 + (colt & 63))); } }
    }
};

struct EpiDown {
    static constexpr bool MID = false;
    float* out; const bf16_t* x1b;
    __device__ __forceinline__ void operator()(const f32x4 (&acc)[2][2][4][2], const Unit& u, int wr, int wc, int fr, int fq) const {
        const int row0 = u.pm * BM + wr * 64 + fr, col0 = u.pn * BM + wc * 32 + 8 * fq;
#pragma unroll
        for (int ai = 0; ai < 2; ++ai)
#pragma unroll
            for (int m = 0; m < 4; ++m) { const size_t r = (size_t)(row0 + ai * HALF + m * 16);
#pragma unroll
                for (int bj = 0; bj < 2; ++bj) { const size_t o = r * D + col0 + bj * HALF;
                    float xb[8]; unpack8(*(const u32x4*)(x1b + o), xb);
                    f32x4 v0 = acc[ai][bj][m][0], v1 = acc[ai][bj][m][1];
#pragma unroll
                    for (int e = 0; e < 4; ++e) { v0[e] += xb[e]; v1[e] += xb[4 + e]; }
                    __builtin_nontemporal_store(v0, (f32x4*)(out + o)); __builtin_nontemporal_store(v1, (f32x4*)(out + o + 4)); } }
    }
};
}

__device__ __forceinline__ void tr_item(const float* W, int ldw, int src_col, int nvalid, const float* kscale, bf16_t* WT, int ldt, int dst_row, int dst_k, LAS float* scr, int lane) {
#pragma unroll 16
    for (int i = 0; i < 32; ++i) { const int kk = 2 * i + (lane >> 5), n = lane & 31;
        float v = (n < nvalid) ? __builtin_nontemporal_load(W + (size_t)kk * ldw + src_col + n) : 0.f;
        if (kscale) v *= kscale[kk];
        scr[kk * 33 + n] = v; }
    LDS_WAIT(); asm volatile("" ::: "memory");
    const int c = lane & 7;
#pragma unroll
    for (int j = 0; j < 4; ++j) { const int n = (lane >> 3) + 8 * j; const LAS float* s = scr + (8 * c) * 33 + n;
        u32x4 o; o.x = pk2(s[0 * 33], s[1 * 33]); o.y = pk2(s[2 * 33], s[3 * 33]); o.z = pk2(s[4 * 33], s[5 * 33]); o.w = pk2(s[6 * 33], s[7 * 33]);
        *(u32x4*)(WT + (size_t)(dst_row + n) * ldt + dst_k + 8 * c) = o; }
    LDS_WAIT(); asm volatile("" ::: "memory");
}
template <int NR>
__device__ __forceinline__ void rms_rows(const float* xrow, const float* g, bf16_t* orow, int lane) {
    f32x4 v[NR][4]; float s[NR];
#pragma unroll
    for (int r = 0; r < NR; ++r)
#pragma unroll
        for (int j = 0; j < 4; ++j) v[r][j] = __builtin_nontemporal_load(((const f32x4*)(xrow + (size_t)r * D)) + lane + 64 * j);
    f32x4 gv[4];
#pragma unroll
    for (int j = 0; j < 4; ++j) gv[j] = ((const f32x4*)g)[lane + 64 * j];
#pragma unroll
    for (int r = 0; r < NR; ++r) { s[r] = 0.f;
#pragma unroll
        for (int j = 0; j < 4; ++j) s[r] += (v[r][j][0] * v[r][j][0] + v[r][j][1] * v[r][j][1]) + (v[r][j][2] * v[r][j][2] + v[r][j][3] * v[r][j][3]); }
#pragma unroll
    for (int o = 1; o < 64; o <<= 1)
#pragma unroll
        for (int r = 0; r < NR; ++r) s[r] += __shfl_xor(s[r], o);
#pragma unroll
    for (int r = 0; r < NR; ++r) { const float rstd = rsqrtf(s[r] * (1.0f / D) + EPS);
#pragma unroll
        for (int j = 0; j < 4; ++j) { const f32x4 o = v[r][j] * rstd * gv[j];
            u32x2 w; w.x = pk2(o[0], o[1]); w.y = pk2(o[2], o[3]); ((u32x2*)(orow + (size_t)r * D))[lane + 64 * j] = w; } }
}
__device__ __forceinline__ void p0_prep(const Args& a, LAS unsigned char* lds, int G) {
    int tid_ = threadIdx.x; asm volatile("" : "+v"(tid_));
    const int tid = tid_, lane = tid & 63, wave = tid >> 6;
    LAS float* scr = (LAS float*)(lds + wave * 16384);
    const int gw = blockIdx.x * 8 + wave, NGW = G * 8;
    unsigned char* ws = a.ws;
    constexpr int I_IN = 16 * 177, I_CAT = 512, I_OUT = 512, I_UP = 2048, I_DN = 2048, I_KV = 256;
    constexpr int NITEMS = I_IN + I_CAT + I_OUT + I_UP + I_DN + I_KV;
    for (int it = gw; it < NITEMS; it += NGW) {
        int r = it;
        if (r < I_IN) { const int kb = r / 177, nb = r % 177, n0 = 32 * nb; int src, nv = 32;
            if (n0 < 1536) src = n0; else if (n0 < 1792) src = 1552 + (n0 - 1536); else if (n0 < 2048) src = 2320 + (n0 - 1792); else if (n0 < 2560) src = 1808 + (n0 - 2048);
            else if (n0 < 5632) src = 2576 + (n0 - 2560); else if (n0 == 5632) { src = 1536; nv = 16; } else { src = 0; nv = 0; }
            tr_item(a.in[3] + (size_t)(64 * kb) * DIN, DIN, src, nv, nullptr, (bf16_t*)(ws + WS_WIN), 1024, n0, 64 * kb, scr, lane); continue; }
        r -= I_IN;
        if (r < I_CAT) { const float* W; int kb, nb, dk;
            if (r < 256) { W = a.in[9]; kb = r / 32; nb = r % 32; dk = 0; } else if (r < 384) { W = a.in[13]; kb = (r - 256) / 32; nb = r % 32; dk = 512; } else { W = a.in[18]; kb = (r - 384) / 32; nb = r % 32; dk = 768; }
            tr_item(W + (size_t)(64 * kb) * D, D, 32 * nb, 32, nullptr, (bf16_t*)(ws + WS_WCAT), 1024, 32 * nb, dk + 64 * kb, scr, lane); continue; }
        r -= I_CAT;
        if (r < I_OUT) { const int kb = r / 32, nb = r % 32;
            tr_item(a.in[19] + (size_t)(64 * kb) * D, D, 32 * nb, 32, nullptr, (bf16_t*)(ws + WS_WOUT), 1024, 32 * nb, 64 * kb, scr, lane); continue; }
        r -= I_OUT;
        if (r < I_UP) { const int kb = r / 128, nb = r % 128;
            tr_item(a.in[21] + (size_t)(64 * kb) * FF, FF, 32 * nb, 32, a.in[20] + 64 * kb, (bf16_t*)(ws + WS_WUP), 1024, 32 * nb, 64 * kb, scr, lane); continue; }
        r -= I_UP;
        if (r < I_DN) { const int kb = r / 32, nb = r % 32;
            tr_item(a.in[22] + (size_t)(64 * kb) * D, D, 32 * nb, 32, nullptr, (bf16_t*)(ws + WS_WDOWN), 4096, 32 * nb, 64 * kb, scr, lane); continue; }
        r -= I_DN;
        { const int kb = r / 16, nb = r % 16;
            tr_item(a.in[15] + (size_t)(64 * kb) * 512, 512, 32 * nb, 32, nullptr, (bf16_t*)(ws + WS_WKV), 1024, 32 * nb, 64 * kb, scr, lane); }
    }
    for (int m = gw * 4; m < T; m += NGW * 4) rms_rows<4>(a.in[0] + (size_t)m * D, a.in[2], (bf16_t*)(ws + WS_H) + (size_t)m * D, lane);
    for (int m = gw; m < NB * 256; m += NGW) rms_rows<1>(a.in[1] + (size_t)m * D, a.in[14], (bf16_t*)(ws + WS_MEMN) + (size_t)m * D, lane);
    float* sumsq = (float*)(ws + WS_SUMSQ);
    for (int i = blockIdx.x * 512 + tid; i < T; i += G * 512) sumsq[i] = 0.f;
}

__device__ __forceinline__ void gates_unit(const Args& a, int pm) {
    int tid_ = threadIdx.x; asm volatile("" : "+v"(tid_));
    const int w = tid_ >> 6, lane = tid_ & 63, fr = lane & 15, fq = lane >> 4;
    const bf16_t* H = (const bf16_t*)(a.ws + WS_H); const bf16_t* Wg = (const bf16_t*)(a.ws + WS_WIN) + (size_t)5632 * 1024;
    const int r0 = pm * 256 + 32 * w;
    f32x4 acc[2] = {{0.f, 0.f, 0.f, 0.f}, {0.f, 0.f, 0.f, 0.f}};
    const bf16_t* wp = Wg + (size_t)fr * 1024 + 8 * fq; const bf16_t* hp0 = H + (size_t)(r0 + fr) * 1024 + 8 * fq; const bf16_t* hp1 = hp0 + (size_t)16 * 1024;
#pragma unroll 8
    for (int kk = 0; kk < 32; ++kk) { const bf16x8 bw = *(const bf16x8*)(wp + 32 * kk);
        acc[0] = mfma16(bw, *(const bf16x8*)(hp0 + 32 * kk), acc[0]); acc[1] = mfma16(bw, *(const bf16x8*)(hp1 + 32 * kk), acc[1]); }
    float* gates = (float*)(a.ws + WS_GATES);
    *(f32x4*)(gates + (size_t)(r0 + fr) * 16 + 4 * fq) = acc[0];
    *(f32x4*)(gates + (size_t)(r0 + 16 + fr) * 16 + 4 * fq) = acc[1];
}
__device__ __forceinline__ void kv_unit(const Args& a, int u) {
    int tid_ = threadIdx.x; asm volatile("" : "+v"(tid_));
    const int w = tid_ >> 6, lane = tid_ & 63, fr = lane & 15, fq = lane >> 4;
    const bf16_t* Mn = (const bf16_t*)(a.ws + WS_MEMN); const bf16_t* Wk = (const bf16_t*)(a.ws + WS_WKV);
    const int row = (u >> 2) * 64 + 16 * (w & 3) + fr, cbase = (u & 3) * 128 + 64 * (w >> 2);
    f32x4 acc[4];
#pragma unroll
    for (int nt = 0; nt < 4; ++nt) acc[nt] = (f32x4){0.f, 0.f, 0.f, 0.f};
    const bf16_t* ap = Mn + (size_t)row * 1024 + 8 * fq; const bf16_t* bp = Wk + (size_t)(cbase + fr) * 1024 + 8 * fq;
#pragma unroll 4
    for (int kk = 0; kk < 32; ++kk) { const bf16x8 av = *(const bf16x8*)(ap + 32 * kk);
#pragma unroll
        for (int nt = 0; nt < 4; ++nt) acc[nt] = mfma16(*(const bf16x8*)(bp + (size_t)nt * 16 * 1024 + 32 * kk), av, acc[nt]); }
    bf16_t* KV = (bf16_t*)(a.ws + WS_KV);
#pragma unroll
    for (int nt = 0; nt < 4; ++nt) { u32x2 o; o.x = pk2(acc[nt][0], acc[nt][1]); o.y = pk2(acc[nt][2], acc[nt][3]);
        *(u32x2*)(KV + (size_t)row * 512 + cbase + 16 * nt + 4 * fq) = o; }
}

struct GateS { float lf, ig, P, Btot; };
__device__ __forceinline__ GateS gate_scalars(const float* gates, const float* b_i, const float* b_f, int tok0, int hd, int dir, int lane) {
    GateS g;
    const float f = gates[(size_t)(tok0 + lane) * 16 + 8 + dir * 4 + hd] + b_f[dir * 4 + hd];
    g.ig = gates[(size_t)(tok0 + lane) * 16 + dir * 4 + hd] + b_i[dir * 4 + hd];
    g.lf = fminf(f, 0.f) - log1pf(__expf(-fabsf(f)));
    float p = g.lf;
#pragma unroll
    for (int o = 1; o < 64; o <<= 1) { const float t = __shfl_up(p, o); if (lane >= o) p += t; }
    g.P = p; g.Btot = __shfl(p, 63);
    return g;
}

constexpr int ML_VS = 272, ML_KS = 144;
constexpr int ML_VIMG = 0, ML_KIMG = 64 * ML_VS, ML_SCAL = ML_KIMG + 2 * 64 * ML_KS, ML_HEAD = ML_SCAL + 2048;

__device__ __forceinline__ void mlstm_local_unit(const Args& a, LAS unsigned char* lds, int unit) {
    int tid_ = threadIdx.x; asm volatile("" : "+v"(tid_));
    const int tid = tid_, lane = tid & 63, w = tid >> 6, hs = w >> 2, hw = w & 3, ht = tid & 255;
    const int hp = unit & 1, c = (unit >> 1) & 127, b = unit >> 8, hd = 2 * hp + hs;
    const int tok0 = b * SEQ + c * 64;
    unsigned char* ws = a.ws;
    const bf16_t* Z = (const bf16_t*)(ws + WS_Z); bf16_t* QKC = (bf16_t*)(ws + WS_QKC);
    LAS unsigned char* L = lds + hs * ML_HEAD;
    LAS float* WSC = (LAS float*)(L + ML_SCAL);
    if (hw < 2) {
        const int dir = hw;
        const GateS g = gate_scalars((const float*)(ws + WS_GATES), a.in[6], a.in[7], tok0, hd, dir, lane);
        const float wlog = dir == 0 ? (g.Btot - g.P + g.ig) : (g.P - g.lf + g.ig);
        const float mloc = wave_max(wlog);
        WSC[dir * 64 + lane] = __expf(wlog - mloc);
        if (lane == 0) { float* sc = (float*)(ws + WS_SC) + (size_t)((((b * 4 + hd) * 2 + dir) * 128 + c)) * 2; sc[0] = mloc; sc[1] = g.Btot; }
    }
#pragma unroll
    for (int i = 0; i < 4; ++i) { const int q = ht + 256 * i, row = q >> 4, ch = q & 15;
        const u32x4 v = *(const u32x4*)(Z + (size_t)(tok0 + row) * ZLD + ZC_V + 128 * hd + 8 * ch);
        *(LAS u32x4*)(L + ML_VIMG + row * ML_VS + ch * 16) = v; }
    LDS_BAR();
    {
        const int ch = ht & 15, tg = ht >> 4;
        const bool isk = ch >= 8;
        const int cidx = isk ? 256 + 64 * hd + 8 * (ch - 8) : 64 * hd + 8 * ch;
        float xr[8][8];
        u32x4 xraw[8];
#pragma unroll
        for (int r = 0; r < 8; ++r) { const int s = 4 * tg - 2 + r, pos = c * 64 + s; const int sc_ = pos < 0 ? s - pos : (pos >= SEQ ? s - (pos - SEQ + 1) : s);
            xraw[r] = *(const u32x4*)(Z + (size_t)(tok0 + sc_) * ZLD + ZC_QK + cidx); }
#pragma unroll
        for (int r = 0; r < 8; ++r) { const int s = 4 * tg - 2 + r, pos = c * 64 + s; const bool ok = pos >= 0 && pos < SEQ;
            unpack8(xraw[r], xr[r]);
#pragma unroll
            for (int e = 0; e < 8; ++e) xr[r][e] = ok ? xr[r][e] : 0.f; }
        float cw[5][8], cb[8];
#pragma unroll
        for (int j = 0; j < 5; ++j) { const f32x4 w0 = *(const f32x4*)(a.in[4] + j * 512 + cidx), w1 = *(const f32x4*)(a.in[4] + j * 512 + cidx + 4);
#pragma unroll
            for (int e = 0; e < 4; ++e) { cw[j][e] = w0[e]; cw[j][4 + e] = w1[e]; } }
        { const f32x4 b0 = *(const f32x4*)(a.in[5] + cidx), b1 = *(const f32x4*)(a.in[5] + cidx + 4);
#pragma unroll
            for (int e = 0; e < 4; ++e) { cb[e] = b0[e]; cb[4 + e] = b1[e]; } }
#pragma unroll
        for (int o = 0; o < 4; ++o) { const int s = 4 * tg + o; float y[8];
#pragma unroll
            for (int e = 0; e < 8; ++e) { float acc = cb[e];
#pragma unroll
                for (int j = 0; j < 5; ++j) acc += cw[j][e] * xr[o + j][e];
                y[e] = acc * __builtin_amdgcn_rcpf(1.0f + __expf(-acc)); }
            if (!isk) {
#pragma unroll
                for (int e = 0; e < 8; ++e) y[e] *= 0.125f;
                __builtin_nontemporal_store(pack8(y), (bf16x8*)(QKC + (size_t)(tok0 + s) * 512 + cidx));
            } else {
                __builtin_nontemporal_store(pack8(y), (bf16x8*)(QKC + (size_t)(tok0 + s) * 512 + cidx));
#pragma unroll
                for (int dir = 0; dir < 2; ++dir) { const float wsv = WSC[dir * 64 + s]; float z[8];
#pragma unroll
                    for (int e = 0; e < 8; ++e) z[e] = y[e] * wsv;
                    *(LAS bf16x8*)(L + ML_KIMG + dir * 64 * ML_KS + s * ML_KS + (ch - 8) * 16) = pack8(z); }
            } }
    }
    LDS_BAR();
    if (ht < 128) { const int dir = ht >> 6, d = ht & 63; float n = 0.f;
        for (int s = 0; s < 64; ++s) n += bf2f(*(LAS const bf16_t*)(L + ML_KIMG + dir * 64 * ML_KS + s * ML_KS + d * 2));
        ((float*)(ws + WS_NS))[(size_t)((((b * 4 + hd) * 2 + dir) * 128 + c)) * 64 + d] = n; }
    {
        const int fr = lane & 15, fq = lane >> 4, q4 = (lane & 15) >> 2, p4 = lane & 3;
        bf16_t* CS = (bf16_t*)(ws + WS_H);
#pragma unroll
        for (int dir = 0; dir < 2; ++dir) {
            bf16x8 af[2];
#pragma unroll
            for (int kk = 0; kk < 2; ++kk) { LAS const unsigned char* p = L + ML_KIMG + dir * 64 * ML_KS + (32 * kk + 8 * fq + q4) * ML_KS + (16 * hw + 4 * p4) * 2;
                af[kk] = cat8(trrd(p), trrd(p + 4 * ML_KS)); }
            bf16_t* cs = CS + (size_t)((((b * 4 + hd) * 2 + dir) * 128 + c)) * 8192;
#pragma unroll
            for (int vt = 0; vt < 8; ++vt) { f32x4 acc = {0.f, 0.f, 0.f, 0.f};
#pragma unroll
                for (int kk = 0; kk < 2; ++kk) { LAS const unsigned char* p = L + ML_VIMG + (32 * kk + 8 * fq + q4) * ML_VS + (16 * vt + 4 * p4) * 2;
                    acc = mfma16(af[kk], cat8(trrd(p), trrd(p + 4 * ML_VS)), acc); }
                u32x2 o; o.x = pk2(acc[0], acc[1]); o.y = pk2(acc[2], acc[3]);
                *(u32x2*)(cs + (16 * vt + fr) * 64 + 16 * hw + 4 * fq) = o; }
        }
    }
    LDS_BAR();
}

__device__ __forceinline__ void scan_step(const f32x2 sc, float& m, float& decay, float& scale) {
    const float mloc = sc[0], Bt = sc[1];
    const float mn = fmaxf(Bt + m, mloc); decay = __expf(Bt + m - mn); scale = __expf(mloc - mn); m = mn;
}
__device__ __forceinline__ void mlstm_scan(const Args& a, int G) {
    unsigned char* ws = a.ws;
    const float* SC = (const float*)(ws + WS_SC); float* MS = (float*)(ws + WS_MS); float* NS = (float*)(ws + WS_NS); unsigned* CS = (unsigned*)(ws + WS_H);
    const float NINF = -__builtin_inff();
    int tid_ = threadIdx.x; asm volatile("" : "+v"(tid_));
    constexpr int SB = 16;
    for (int idx = blockIdx.x * 512 + tid_; idx < 131072; idx += G * 512) {
        const int chain = idx >> 12, e = idx & 4095, dir = chain & 1;
        const long cstep = dir ? -1 : 1; const size_t c0 = (size_t)chain * 128 + (dir ? 127 : 0);
        float m = NINF, s0 = 0.f, s1 = 0.f;
        for (int st0 = 0; st0 < 128; st0 += SB) {
            unsigned loc[SB]; f32x2 sc[SB];
            unsigned* p = CS + (size_t)((long)c0 + cstep * st0) * 4096 + e; const float* q = SC + (size_t)((long)c0 + cstep * st0) * 2;
#pragma unroll
            for (int j = 0; j < SB; ++j) { loc[j] = p[(long)j * cstep * 4096]; sc[j] = *(const f32x2*)(q + (long)j * cstep * 2); }
#pragma unroll
            for (int j = 0; j < SB; ++j) { float decay, scale; const float mprev = m; scan_step(sc[j], m, decay, scale);
                p[(long)j * cstep * 4096] = pk2(s0, s1); s0 = decay * s0 + scale * bflo(loc[j]); s1 = decay * s1 + scale * bfhi(loc[j]);
                if (e == 0) MS[(long)c0 + cstep * (st0 + j)] = mprev; }
        }
    }
    for (int idx = blockIdx.x * 512 + tid_; idx < 2048; idx += G * 512) {
        const int chain = idx >> 6, e = idx & 63, dir = chain & 1;
        const long cstep = dir ? -1 : 1; const size_t c0 = (size_t)chain * 128 + (dir ? 127 : 0);
        float m = NINF, s0 = 0.f;
        for (int st0 = 0; st0 < 128; st0 += SB) {
            float nl[SB]; f32x2 sc[SB];
            float* p = NS + (size_t)((long)c0 + cstep * st0) * 64 + e; const float* q = SC + (size_t)((long)c0 + cstep * st0) * 2;
#pragma unroll
            for (int j = 0; j < SB; ++j) { nl[j] = p[(long)j * cstep * 64]; sc[j] = *(const f32x2*)(q + (long)j * cstep * 2); }
#pragma unroll
            for (int j = 0; j < SB; ++j) { float decay, scale; scan_step(sc[j], m, decay, scale);
                p[(long)j * cstep * 64] = s0; s0 = decay * s0 + scale * nl[j]; }
        }
    }
}

__device__ __forceinline__ void mlstm_out_unit(const Args& a, LAS unsigned char* lds, int unit, bool dummy = false) {
    int tid_ = threadIdx.x; asm volatile("" : "+v"(tid_));
    const int tid = tid_, lane = tid & 63, w = tid >> 6, hs = w >> 2, hw = w & 3, ht = tid & 255;
    const int hp = unit & 1, c = (unit >> 1) & 127, b = unit >> 8, hd = 2 * hp + hs;
    const int tok0 = b * SEQ + c * 64;
    unsigned char* ws = a.ws;
    bf16_t* Z = (bf16_t*)(ws + WS_Z); const bf16_t* QKC = (const bf16_t*)(ws + WS_QKC);
    LAS unsigned char* L = lds + hs * ML_HEAD;
    LAS float* SA = (LAS float*)(L + ML_SCAL);
    const float* MS = (const float*)(ws + WS_MS);
    const int tt = hw, fr = lane & 15, fq = lane >> 4, q4 = (lane & 15) >> 2, p4 = lane & 3;
    const int t = 16 * tt + fr;
    bf16x8 qf[2], kfr[4][2];
#pragma unroll
    for (int kk = 0; kk < 2; ++kk) qf[kk] = *(const bf16x8*)(QKC + (size_t)(tok0 + t) * 512 + 64 * hd + 32 * kk + 8 * fq);
#pragma unroll
    for (int st = 0; st < 4; ++st)
#pragma unroll
        for (int kk = 0; kk < 2; ++kk) kfr[st][kk] = *(const bf16x8*)(QKC + (size_t)(tok0 + 16 * st + fr) * 512 + 256 + 64 * hd + 32 * kk + 8 * fq);
    f32x4 nsv[2][4];
#pragma unroll
    for (int dir = 0; dir < 2; ++dir) { const float* ns = (const float*)(ws + WS_NS) + (size_t)(((b * 4 + hd) * 2 + dir) * 128 + c) * 64;
#pragma unroll
        for (int kk = 0; kk < 2; ++kk) { nsv[dir][2 * kk] = *(const f32x4*)(ns + 32 * kk + 8 * fq); nsv[dir][2 * kk + 1] = *(const f32x4*)(ns + 32 * kk + 8 * fq + 4); } }
    bf16_t* orow = Z + (size_t)(tok0 + t) * ZLD + ZC_O + 128 * hd;
    u32x2 ogv[8];
#pragma unroll
    for (int vt = 0; vt < 8; ++vt) ogv[vt] = *(const u32x2*)(orow + 16 * vt + 4 * fq);
    f32x4 sacc[4];
#pragma unroll
    for (int st = 0; st < 4; ++st) { sacc[st] = (f32x4){0.f, 0.f, 0.f, 0.f};
#pragma unroll
        for (int kk = 0; kk < 2; ++kk) sacc[st] = mfma16(kfr[st][kk], qf[kk], sacc[st]); }
    if (hw < 2) {
        const int dir = hw;
        const GateS g = gate_scalars((const float*)(ws + WS_GATES), a.in[6], a.in[7], tok0, hd, dir, lane);
        const float bcum = dir == 0 ? g.P : (g.Btot - g.P + g.lf);
        const float as = g.ig - bcum;
        const float mst = MS[(size_t)(((b * 4 + hd) * 2 + dir) * 128 + c)];
        float cm = as;
        if (dir == 0) {
#pragma unroll
            for (int o = 1; o < 64; o <<= 1) { const float t = __shfl_up(cm, o); if (lane >= o) cm = fmaxf(cm, t); }
        } else {
#pragma unroll
            for (int o = 1; o < 64; o <<= 1) { const float t = __shfl_down(cm, o); if (lane + o < 64) cm = fmaxf(cm, t); }
        }
        SA[(dir * 3 + 0) * 64 + lane] = as; SA[(dir * 3 + 1) * 64 + lane] = fmaxf(cm, mst); SA[(dir * 3 + 2) * 64 + lane] = bcum;
        if (lane == 0) SA[6 * 64 + dir] = mst;
    }
#pragma unroll
    for (int i = 0; i < 4; ++i) { const int q = ht + 256 * i, row = q >> 4, ch = q & 15;
        const u32x4 v = *(const u32x4*)(Z + (size_t)(tok0 + row) * ZLD + ZC_V + 128 * hd + 8 * ch);
        *(LAS u32x4*)(L + ML_VIMG + row * ML_VS + ch * 16) = v; }
    LDS_BAR();
    {
        float qv[16];
        { unpack8(__builtin_bit_cast(u32x4, qf[0]), qv); unpack8(__builtin_bit_cast(u32x4, qf[1]), qv + 8); }
        f32x4 hsum[8];
#pragma unroll
        for (int vt = 0; vt < 8; ++vt) hsum[vt] = (f32x4){0.f, 0.f, 0.f, 0.f};
#pragma unroll 1
        for (int dir = 0; dir < 2; ++dir) {
            const size_t cc = (size_t)(((b * 4 + hd) * 2 + dir) * 128 + c);
            const float amax = SA[(dir * 3 + 1) * 64 + t], bq = SA[(dir * 3 + 2) * 64 + t], mst = SA[6 * 64 + dir];
            const float winter = __expf(mst - amax);
            float p[4][4]; float den = 0.f;
#pragma unroll
            for (int st = 0; st < 4; ++st) { const f32x4 a4 = *(LAS const f32x4*)(SA + (dir * 3 + 0) * 64 + 16 * st + 4 * fq);
#pragma unroll
                for (int j = 0; j < 4; ++j) { const int s = 16 * st + 4 * fq + j; const bool valid = dir == 0 ? (s <= t) : (s >= t);
                    const float e = __expf(fminf(a4[j] - amax, 0.f));
                    p[st][j] = valid ? sacc[st][j] * e : 0.f; den += p[st][j]; } }
            den = quad_sum(den);
            bf16x8 pb[2];
#pragma unroll
            for (int kk = 0; kk < 2; ++kk) { float v8[8];
#pragma unroll
                for (int j = 0; j < 4; ++j) { v8[j] = p[2 * kk][j]; v8[4 + j] = p[2 * kk + 1][j]; }
                pb[kk] = pack8(v8); }
            float dot = 0.f;
#pragma unroll
            for (int kk = 0; kk < 2; ++kk) { const f32x4 n0 = dir ? nsv[1][2 * kk] : nsv[0][2 * kk], n1 = dir ? nsv[1][2 * kk + 1] : nsv[0][2 * kk + 1];
#pragma unroll
                for (int j = 0; j < 4; ++j) dot += qv[8 * kk + j] * n0[j] + qv[8 * kk + 4 + j] * n1[j]; }
            dot = quad_sum(dot);
            const float dent = den + winter * dot;
            const float inv = __builtin_amdgcn_rcpf(fmaxf(fabsf(dent), __expf(-(bq + amax))));
            const bf16_t* cs = (const bf16_t*)(ws + WS_H) + cc * 8192;
#pragma unroll
            for (int vt = 0; vt < 8; ++vt) { f32x4 a1 = {0.f, 0.f, 0.f, 0.f}, a2 = {0.f, 0.f, 0.f, 0.f};
#pragma unroll
                for (int kk = 0; kk < 2; ++kk) { LAS const unsigned char* pp = L + ML_VIMG + (32 * kk + 4 * fq + q4) * ML_VS + (16 * vt + 4 * p4) * 2;
                    a1 = mfma16(cat8(trrd(pp), trrd(pp + 16 * ML_VS)), pb[kk], a1);
                    const bf16x8 cf = *(const bf16x8*)(cs + (16 * vt + fr) * 64 + 32 * kk + 8 * fq);
                    a2 = mfma16(cf, qf[kk], a2); }
                hsum[vt] += (a1 + a2 * winter) * inv; }
        }
        float ss = 0.f;
#pragma unroll
        for (int vt = 0; vt < 8; ++vt) ss += (hsum[vt][0] * hsum[vt][0] + hsum[vt][1] * hsum[vt][1]) + (hsum[vt][2] * hsum[vt][2] + hsum[vt][3] * hsum[vt][3]);
        ss = quad_sum(ss);
        const float rstd = rsqrtf(ss * (1.0f / 128.0f) + EPS);
        const float* gm = a.in[8] + 128 * hd;
#pragma unroll
        for (int vt = 0; vt < 8; ++vt) { const int v0 = 16 * vt + 4 * fq; const u32x2 og = ogv[vt]; const f32x4 gv = *(const f32x4*)(gm + v0);
            const float o0 = hsum[vt][0] * rstd * gv[0] * bflo(og.x), o1 = hsum[vt][1] * rstd * gv[1] * bfhi(og.x), o2 = hsum[vt][2] * rstd * gv[2] * bflo(og.y), o3 = hsum[vt][3] * rstd * gv[3] * bfhi(og.y);
            u32x2 o; o.x = pk2(o0, o1); o.y = pk2(o2, o3); if (dummy) *(u32x2*)((bf16_t*)a.out + (size_t)(tok0 + t) * 1024 + 128 * hd + v0) = o; else *(u32x2*)(orow + v0) = o; }
    }
    LDS_BAR();
}

constexpr int NA_VS = 80, NA_RPB = 512 * NA_VS, NA_HEAD = NA_RPB + 2176;
__device__ __forceinline__ void na_stage_rpb(const Args& a, LAS unsigned char* lds, int hp) {
    int tid_ = threadIdx.x; asm volatile("" : "+v"(tid_));
    const int hs = tid_ >> 8, ht = tid_ & 255, hd = 2 * hp + hs;
    LAS float* RPB = (LAS float*)(lds + hs * NA_HEAD + NA_RPB) + 32;
    const float v0 = a.in[12][hd * 465 + ht], v1 = (ht + 256 < 465) ? a.in[12][hd * 465 + ht + 256] : 0.f;
    RPB[ht] = v0 * 1.4426950408889634f; if (ht + 256 < 465) RPB[ht + 256] = v1 * 1.4426950408889634f;
    LDS_BAR();
}
__device__ __forceinline__ void na_group(const Args& a, LAS unsigned char* lds, int g) {
    int tid_ = threadIdx.x; asm volatile("" : "+v"(tid_));
    const int tid = tid_, lane = tid & 63, w = tid >> 6, hs = w >> 2, qt = w & 3, ht = tid & 255;
    const int hp = g & 3, b = (g >> 2) & 3, r0 = (g >> 4) * 8, hd = 2 * hp + hs;
    const char* Zb = (const char*)(a.ws + WS_Z);
    bf16_t* Z = (bf16_t*)(a.ws + WS_Z);
    LAS unsigned char* L = lds + hs * NA_HEAD;
    LAS float* RPB = (LAS float*)(L + NA_RPB) + 32;
    const int fr = lane & 15, fq = lane >> 4, q4 = (lane & 15) >> 2, p4 = lane & 3;
    const int c0 = 16 * qt, cb = qt == 0 ? 0 : (qt == 1 ? 8 : (qt == 2 ? 24 : 32));
    const int qcol = c0 + fr;
    const unsigned rowb = (unsigned)ZLD * 2u;
    const unsigned qoff = (unsigned)(b * SEQ + qcol) * rowb + (unsigned)(ZC_QNA + 32 * hd + 8 * fq) * 2u;
    const unsigned koff = (unsigned)(b * SEQ + cb + fr) * rowb + (unsigned)(ZC_KNA + 32 * hd + 8 * fq) * 2u;
    const int vcol = ht >> 2, vch = ht & 3;
    const unsigned voff = (unsigned)(b * SEQ + vcol) * rowb + (unsigned)(ZC_VNA + 32 * hd + 8 * vch) * 2u;
    const int cs = qcol < 8 ? 0 : (qcol - 8 > 48 ? 48 : qcol - 8);
    const int lv = cb + 4 * fq - cs;
    int rs = r0 < 4 ? 0 : (r0 - 4 > 120 ? 120 : r0 - 4);
    bf16x8 qf = *(const bf16x8*)(Zb + (qoff + (unsigned)(r0 * 64) * rowb));
    bf16x8 kf[16];
#pragma unroll
    for (int i = 0; i < 8; ++i)
#pragma unroll
        for (int hf = 0; hf < 2; ++hf) kf[i * 2 + hf] = *(const bf16x8*)(Zb + (koff + (unsigned)((rs + i) * 64 + 16 * hf) * rowb));
    {
        u32x4 v[8];
#pragma unroll
        for (int i = 0; i < 8; ++i) v[i] = *(const u32x4*)(Zb + (voff + (unsigned)((rs + i) * 64) * rowb));
#pragma unroll
        for (int i = 0; i < 8; ++i) *(LAS u32x4*)(L + ((((rs + i) & 7) * 64 + vcol) * NA_VS) + vch * 16) = v[i];
    }
#pragma unroll 1
    for (int rr = 0; rr < 8; ++rr) {
        const int r = r0 + rr;
        f32x4 sacc[16];
#pragma unroll
        for (int k = 0; k < 16; ++k) sacc[k] = mfma16(kf[k], qf, (f32x4){0.f, 0.f, 0.f, 0.f});
        LDS_BAR();
        const int rn = r + 1, rsn = rn < 4 ? 0 : (rn - 4 > 120 ? 120 : rn - 4);
        const bool more = rr < 7, slide = more && rsn != rs;
        bf16x8 qn = qf, kn0 = kf[14], kn1 = kf[15]; u32x4 vn = {0u, 0u, 0u, 0u};
        if (more) qn = *(const bf16x8*)(Zb + (qoff + (unsigned)(rn * 64) * rowb));
        if (slide) { kn0 = *(const bf16x8*)(Zb + (koff + (unsigned)((rsn + 7) * 64) * rowb)); kn1 = *(const bf16x8*)(Zb + (koff + (unsigned)((rsn + 7) * 64 + 16) * rowb));
            vn = *(const u32x4*)(Zb + (voff + (unsigned)((rsn + 7) * 64) * rowb)); }
        {
            const LAS float* bp = RPB + ((rs - r + 7) * 31 + (cb - c0 + 15) + 4 * fq - fr);
            const float NINF = -__builtin_inff();
            float mx = NINF;
#pragma unroll
            for (int i = 0; i < 8; ++i)
#pragma unroll
                for (int hf = 0; hf < 2; ++hf)
#pragma unroll
                    for (int j = 0; j < 4; ++j) { const bool valid = (unsigned)(lv + 16 * hf + j) < 16u;
                        const float sc = valid ? sacc[i * 2 + hf][j] + bp[31 * i + 16 * hf + j] : NINF;
                        sacc[i * 2 + hf][j] = sc; mx = fmaxf(mx, sc); }
            mx = quad_max(mx);
            float sum = 0.f;
#pragma unroll
            for (int k = 0; k < 16; ++k)
#pragma unroll
                for (int j = 0; j < 4; ++j) { const float e = __builtin_amdgcn_exp2f(sacc[k][j] - mx); sacc[k][j] = e; sum += e; }
            sum = quad_sum(sum);
            const float inv = __builtin_amdgcn_rcpf(sum);
            f32x4 o[2] = {{0.f, 0.f, 0.f, 0.f}, {0.f, 0.f, 0.f, 0.f}};
#pragma unroll
            for (int i = 0; i < 8; ++i) { float v8[8];
#pragma unroll
                for (int j = 0; j < 4; ++j) { v8[j] = sacc[2 * i][j]; v8[4 + j] = sacc[2 * i + 1][j]; }
                const bf16x8 pb = pack8(v8);
                const int slot = (rs + i) & 7;
#pragma unroll
                for (int dt = 0; dt < 2; ++dt) { LAS const unsigned char* pp = L + (slot * 64 + cb + 4 * fq + q4) * NA_VS + (16 * dt + 4 * p4) * 2;
                    o[dt] = mfma16(cat8(trrd(pp), trrd(pp + 16 * NA_VS)), pb, o[dt]); } }
            const size_t tokq = (size_t)b * SEQ + r * 64 + qcol;
#pragma unroll
            for (int dt = 0; dt < 2; ++dt) { u32x2 ov; ov.x = pk2(o[dt][0] * inv, o[dt][1] * inv); ov.y = pk2(o[dt][2] * inv, o[dt][3] * inv);
                *(u32x2*)(Z + tokq * ZLD + ZC_QNA + 32 * hd + 16 * dt + 4 * fq) = ov; }
        }
        LDS_BAR();
        if (slide) {
            *(LAS u32x4*)(L + ((((rsn + 7) & 7) * 64 + vcol) * NA_VS) + vch * 16) = vn;
#pragma unroll
            for (int k = 0; k < 14; ++k) kf[k] = kf[k + 2];
            kf[14] = kn0; kf[15] = kn1; rs = rsn;
        }
        qf = qn;
    }
}

constexpr int MA_S = 144, MA_K = 0, MA_V = 256 * MA_S;
__device__ __forceinline__ void memattn_unit(const Args& a, LAS unsigned char* lds, int unit, bool dummy = false) {
    int tid_ = threadIdx.x; asm volatile("" : "+v"(tid_));
    const int tid = tid_, lane = tid & 63, w = tid >> 6;
    const int tile = unit & 63, hd = (unit >> 6) & 3, b = unit >> 8;
    unsigned char* ws = a.ws;
    bf16_t* Z = (bf16_t*)(ws + WS_Z); const bf16_t* KV = (const bf16_t*)(ws + WS_KV);
#pragma unroll
    for (int i = 0; i < 4; ++i) { const int q = tid + 512 * i, m = q >> 3, ch = q & 7;
        const bf16_t* src = KV + (size_t)(b * 256 + m) * 512 + 64 * hd + 8 * ch;
        float v[8]; unpack8(*(const u32x4*)src, v); float ss = 0.f;
#pragma unroll
        for (int e = 0; e < 8; ++e) ss += v[e] * v[e];
        ss += __shfl_xor(ss, 1); ss += __shfl_xor(ss, 2); ss += __shfl_xor(ss, 4);
        const float rstd = rsqrtf(ss * (1.0f / 64.0f) + EPS);
        const f32x4 g0 = *(const f32x4*)(a.in[17] + 8 * ch), g1 = *(const f32x4*)(a.in[17] + 8 * ch + 4);
#pragma unroll
        for (int e = 0; e < 4; ++e) { v[e] *= rstd * g0[e]; v[4 + e] *= rstd * g1[e]; }
        *(LAS bf16x8*)(lds + MA_K + m * MA_S + ch * 16) = pack8(v);
        *(LAS u32x4*)(lds + MA_V + m * MA_S + ch * 16) = *(const u32x4*)(src + 256); }
    LDS_BAR();
    {
        const int fr = lane & 15, fq = lane >> 4, q4 = (lane & 15) >> 2, p4 = lane & 3;
        const size_t tok = (size_t)b * SEQ + tile * 128 + 16 * w + fr;
        bf16_t* qrow = Z + tok * ZLD + ZC_QMEM + 64 * hd;
        bf16x8 qf[2];
        { float v[16]; unpack8(*(const u32x4*)(qrow + 8 * fq), v); unpack8(*(const u32x4*)(qrow + 32 + 8 * fq), v + 8); float ss = 0.f;
#pragma unroll
            for (int e = 0; e < 16; ++e) ss += v[e] * v[e];
            ss = quad_sum(ss); const float rstd = rsqrtf(ss * (1.0f / 64.0f) + EPS) * 0.125f;
#pragma unroll
            for (int kk = 0; kk < 2; ++kk) { const f32x4 g0 = *(const f32x4*)(a.in[16] + 32 * kk + 8 * fq), g1 = *(const f32x4*)(a.in[16] + 32 * kk + 8 * fq + 4);
#pragma unroll
                for (int e = 0; e < 4; ++e) { v[8 * kk + e] *= rstd * g0[e]; v[8 * kk + 4 + e] *= rstd * g1[e]; }
                qf[kk] = pack8(v + 8 * kk); } }
        f32x4 sacc[16];
        float mx = -__builtin_inff();
#pragma unroll
        for (int kt = 0; kt < 16; ++kt) { f32x4 s = {0.f, 0.f, 0.f, 0.f};
#pragma unroll
            for (int kk = 0; kk < 2; ++kk) s = mfma16(*(LAS const bf16x8*)(lds + MA_K + (16 * kt + fr) * MA_S + (32 * kk + 8 * fq) * 2), qf[kk], s);
            sacc[kt] = s; mx = fmaxf(mx, fmaxf(fmaxf(s[0], s[1]), fmaxf(s[2], s[3]))); }
        mx = quad_max(mx);
        float sum = 0.f;
#pragma unroll
        for (int kt = 0; kt < 16; ++kt)
#pragma unroll
            for (int j = 0; j < 4; ++j) { const float e = __expf(sacc[kt][j] - mx); sacc[kt][j] = e; sum += e; }
        sum = quad_sum(sum);
        const float inv = __builtin_amdgcn_rcpf(sum);
        f32x4 o[4];
#pragma unroll
        for (int dt = 0; dt < 4; ++dt) o[dt] = (f32x4){0.f, 0.f, 0.f, 0.f};
#pragma unroll
        for (int ks = 0; ks < 8; ++ks) { float v8[8];
#pragma unroll
            for (int j = 0; j < 4; ++j) { v8[j] = sacc[2 * ks][j]; v8[4 + j] = sacc[2 * ks + 1][j]; }
            const bf16x8 pb = pack8(v8);
#pragma unroll
            for (int dt = 0; dt < 4; ++dt) { LAS const unsigned char* pp = lds + MA_V + (32 * ks + 4 * fq + q4) * MA_S + (16 * dt + 4 * p4) * 2;
                o[dt] = mfma16(cat8(trrd(pp), trrd(pp + 16 * MA_S)), pb, o[dt]); } }
#pragma unroll
        for (int dt = 0; dt < 4; ++dt) { u32x2 ov; ov.x = pk2(o[dt][0] * inv, o[dt][1] * inv); ov.y = pk2(o[dt][2] * inv, o[dt][3] * inv);
            if (dummy) *(u32x2*)((bf16_t*)a.out + tok * 1024 + 64 * hd + 16 * dt + 4 * fq) = ov; else *(u32x2*)(qrow + 16 * dt + 4 * fq) = ov; }
    }
    LDS_BAR();
}

#define XB_TMO      128
#define XB_XCNT(j)  (256  + 64 * (j))
#define XB_XSUB(j)  (1280 + 64 * (j))
#define XB_XGEN(j)  (2304 + 64 * (j))
#define XB_TOP      3328
#define XB_TOPGEN   3392
#define XCD_BAR_WORDS 3456
#define XB_SPIN_CAP (1u << 22)
__device__ __forceinline__ unsigned xb_ld(unsigned* p)              { return __hip_atomic_load(p, __ATOMIC_RELAXED, __HIP_MEMORY_SCOPE_AGENT); }
__device__ __forceinline__ unsigned xb_add(unsigned* p, unsigned v) { return __hip_atomic_fetch_add(p, v, __ATOMIC_RELAXED, __HIP_MEMORY_SCOPE_AGENT); }
__device__ __forceinline__ unsigned xb_xcc_id() { return (unsigned)__builtin_amdgcn_s_getreg((3 << 11) | 20) & 0xFu; }
#define XB_SPIN(cond, bar) do { unsigned _sp = 0; while (cond) { __builtin_amdgcn_s_sleep(1); \
    if ((++_sp & 255u) == 0u) { if (xb_ld(&(bar)[XB_TMO])) break; if (_sp > XB_SPIN_CAP) { atomicAdd(&(bar)[XB_TMO], 1u); break; } } } } while (0)
struct XcdBarrier { unsigned* bar; unsigned x; volatile LAS unsigned* st; };
__device__ __forceinline__ XcdBarrier xcd_barrier_post(unsigned* bar, volatile LAS unsigned* st) {
    XcdBarrier b; b.bar = bar; b.x = xb_xcc_id(); b.st = st;
    if (threadIdx.x == 0) (void)xb_add(&bar[XB_XCNT(b.x)], 1u);
    return b;
}
__device__ __forceinline__ void xcd_barrier_complete(unsigned* bar, unsigned x, unsigned& nloc, unsigned& nx) {
    const unsigned G = gridDim.x * gridDim.y * gridDim.z;
    unsigned sum, cnt, mine, sp = 0u;
    for (;;) {
        sum = 0u; cnt = 0u; mine = 0u;
#pragma unroll
        for (unsigned j = 0; j < 16; ++j) { const unsigned c = xb_ld(&bar[XB_XCNT(j)]); sum += c; cnt += (c > 0u) ? 1u : 0u; mine = (j == x) ? c : mine; }
        if (sum == G) break;
        __builtin_amdgcn_s_sleep(1);
        if ((++sp & 255u) == 0u) { if (xb_ld(&bar[XB_TMO])) break; if (sp > XB_SPIN_CAP) { atomicAdd(&bar[XB_TMO], 1u); break; } }
    }
    nloc = mine > 0u ? mine : 1u; nx = cnt > 0u ? cnt : 1u;
}
__device__ __forceinline__ void xcd_barrier(const XcdBarrier& b) {
    asm volatile("s_waitcnt vmcnt(0)" ::: "memory");
    __syncthreads();
    if (threadIdx.x == 0) {
        unsigned* bar = b.bar;
        __builtin_amdgcn_s_waitcnt(0);
        unsigned nloc = b.st[0], nx = b.st[1];
        if (nloc == 0u) { xcd_barrier_complete(bar, b.x, nloc, nx); b.st[0] = nloc; b.st[1] = nx; }
        const unsigned round = b.st[3]; b.st[3] = round + 1u;
        const unsigned old = xb_add(&bar[XB_XSUB(b.x)], 1u);
        if (old + 1u == (round + 1u) * nloc) {
            __builtin_amdgcn_fence(__ATOMIC_RELEASE, "agent");
            asm volatile("s_waitcnt vmcnt(0)" ::: "memory");
            (void)xb_add(&bar[XB_TOP], 1u);
        }
        const unsigned target = (round + 1u) * nx;
        XB_SPIN(xb_ld(&bar[XB_TOP]) < target, bar);
        __builtin_amdgcn_fence(__ATOMIC_ACQUIRE, "agent");
        asm volatile("s_waitcnt vmcnt(0)" ::: "memory");
    }
    __syncthreads();
}

__global__ void __launch_bounds__(512, 2) hybrid_fwd(Args a) {
    extern __shared__ __attribute__((aligned(16))) unsigned char lds_raw[];
    LAS unsigned char* lds = (LAS unsigned char*)lds_raw;
    cg::grid_group grid = cg::this_grid();
#ifdef USE_CG_SYNC
#define GRID_SYNC() do { asm volatile("s_waitcnt vmcnt(0) lgkmcnt(0)" ::: "memory"); grid.sync(); } while (0)
#else
    if (threadIdx.x < 4) ((volatile LAS unsigned*)(lds + LDS_BYTES - 64))[threadIdx.x] = 0u;
    __syncthreads();
    const XcdBarrier xbar = xcd_barrier_post((unsigned*)(a.ws + WS_BAR), (volatile LAS unsigned*)(lds + LDS_BYTES - 64));
    if (!grid.is_valid()) return;
#define GRID_SYNC() xcd_barrier(xbar)
#endif
    const int G = gridDim.x, bx = blockIdx.x;
    unsigned char* ws = a.ws;

#ifndef PH_MASK
#define PH_MASK 0x1ff
#endif
#ifndef REP0
#define REP0 1
#define REP1 1
#define REP2L 1
#define REP3 1
#define REP5 1
#endif
#ifndef REPNA
#define REPNA 1
#endif
#ifndef REPMO
#define REPMO 1
#endif
#ifndef REPMA
#define REPMA 1
#endif
    if (PH_MASK & 1) p0_prep(a, lds, G);
    if (REP0 > 1) { GRID_SYNC(); p0_prep(a, lds, G); }
    GRID_SYNC();
    if (PH_MASK & 2) {
        pg8::Gemm g{1024, 1024, 16, 128};
        pg8::Sched S; S.nM = T / 256; S.nN = NIN / 256; S.nwg = S.nM * S.nN; S.G = G; S.c = bx;
        S.A = (const char*)(ws + WS_H); S.B = (const char*)(ws + WS_WIN); S.tA = (size_t)256 * 1024 * 2; S.tB = (size_t)256 * 1024 * 2;
        S.nextra = 0; S.nN2 = 1; S.pnb2 = 0; S.A2 = S.A; S.B2 = S.B; S.tA2 = 0; S.tB2 = 0;
        pg8::EpiZ E{(bf16_t*)(ws + WS_Z), a.in[10], a.in[11]};
        pg8::gemm_phase<pg8::EpiZ, true>(lds, g, S, E);
        for (int u = bx; u < 128 + 64; u += G) { if (u < 128) gates_unit(a, u); else kv_unit(a, u - 128); }
    }
    if (REP1 > 1) { GRID_SYNC(); {
        pg8::Gemm g{1024, 1024, 16, 128};
        pg8::Sched S; S.nM = T / 256; S.nN = NIN / 256; S.nwg = S.nM * S.nN; S.G = G; S.c = bx;
        S.A = (const char*)(ws + WS_H); S.B = (const char*)(ws + WS_WIN); S.tA = (size_t)256 * 1024 * 2; S.tB = (size_t)256 * 1024 * 2;
        S.nextra = 0; S.nN2 = 1; S.pnb2 = 0; S.A2 = S.A; S.B2 = S.B; S.tA2 = 0; S.tB2 = 0;
        pg8::EpiZ E{(bf16_t*)(ws + WS_Z), a.in[10], a.in[11]};
        pg8::gemm_phase<pg8::EpiZ, true>(lds, g, S, E);
        for (int u = bx; u < 128 + 64; u += G) { if (u < 128) gates_unit(a, u); else kv_unit(a, u - 128); }
    } }
    GRID_SYNC();
#if defined(DBG_STOP) && DBG_STOP == 1
    { GRID_SYNC(); const bf16_t* Zb = (const bf16_t*)(ws + WS_Z); const float* gt = (const float*)(ws + WS_GATES); const bf16_t* kvb = (const bf16_t*)(ws + WS_KV);
      for (size_t i = (size_t)bx * 512 + threadIdx.x; i < (size_t)T * D; i += (size_t)G * 512) { const size_t t = i >> 10, j = i & 1023; float v = 0.f;
          for (int q = 0; q < 6; ++q) { const size_t col = j + 1024 * q; if (col < ZLD) v += bf2f(Zb[t * ZLD + col]); }
          v += gt[t * 16 + (j & 15)]; v += bf2f(kvb[(t & 1023) * 512 + (j & 511)]);
          a.out[i] = v; }
      return; }
#endif
#ifndef DBG_SUB
#define DBG_SUB 0
#endif
    if (PH_MASK & 4) {
        int u = bx;
        for (; u < 1024; u += G) { mlstm_local_unit(a, lds, u); if (REP2L > 1) mlstm_local_unit(a, lds, u); }
        { int last_hp = -1;
          for (int g = bx; g < 256; g += G) { const int hp = g & 3; if (hp != last_hp) { na_stage_rpb(a, lds, hp); last_hp = hp; } na_group(a, lds, g); } }
    }
    GRID_SYNC();
#if defined(DBG_STOP) && DBG_STOP == 2
    { GRID_SYNC(); const bf16_t* Zb = (const bf16_t*)(ws + WS_Z); const bf16_t* csb = (const bf16_t*)(ws + WS_H); const bf16_t* qk = (const bf16_t*)(ws + WS_QKC); const float* nsb = (const float*)(ws + WS_NS); const float* scb = (const float*)(ws + WS_SC);
      for (size_t i = (size_t)bx * 512 + threadIdx.x; i < (size_t)T * D; i += (size_t)G * 512) { const size_t t = i >> 10, j = i & 1023; float v;
#if DBG_SUB == 2
          v = bf2f(Zb[t * ZLD + ZC_QNA + (j & 255)]);
#elif DBG_SUB == 3
          v = bf2f(qk[t * 512 + (j & 511)]);
#elif DBG_SUB == 4
          v = (j < 1020) ? bf2f(csb[i]) : 0.f;
#elif DBG_SUB == 5
          v = (j < 512) ? nsb[(i >> 2) & 262143] : scb[(i >> 1) & 8191];
#else
          if (j < 256) v = 0.f; else if (j < 768) v = bf2f(qk[t * 512 + (j - 256)]); else if (j < 1020) v = bf2f(csb[i]); else if (j < 1022) v = nsb[(i >> 2) & 262143]; else v = scb[(i >> 1) & 8191];
#endif
          a.out[i] = v; }
      return; }
#endif
#ifdef XSYNC
    for (int q = 0; q < XSYNC; ++q) GRID_SYNC();
#endif
    if (PH_MASK & 8) mlstm_scan(a, G);
    GRID_SYNC();
    if (PH_MASK & 16) for (int u = bx; u < 2048; u += G) { if (u < 1024) { if (REPMO > 1) mlstm_out_unit(a, lds, u, true); mlstm_out_unit(a, lds, u); } else { if (REPMA > 1) memattn_unit(a, lds, u - 1024, true); memattn_unit(a, lds, u - 1024); } }
    GRID_SYNC();
#if defined(DBG_STOP) && DBG_STOP == 4
    { GRID_SYNC(); const bf16_t* Zb = (const bf16_t*)(ws + WS_Z);
      for (size_t i = (size_t)bx * 512 + threadIdx.x; i < (size_t)T * D; i += (size_t)G * 512) { const size_t t = i >> 10, j = i & 1023;
          a.out[i] = bf2f(Zb[t * ZLD + 1024 + j]); }
      return; }
#endif
    if (PH_MASK & 32) {
        pg8::Gemm g{ZLD, 1024, 16, 128};
        pg8::Sched S; S.nM = T / 256; S.nN = 4; S.nwg = S.nM * S.nN; S.G = G; S.c = bx;
        S.A = (const char*)(ws + WS_Z) + ZC_O * 2; S.B = (const char*)(ws + WS_WCAT); S.tA = (size_t)256 * ZLD * 2; S.tB = (size_t)256 * 1024 * 2;
        S.nextra = 0; S.nN2 = 1; S.pnb2 = 0; S.A2 = S.A; S.B2 = S.B; S.tA2 = 0; S.tB2 = 0;
        pg8::EpiMerge E{(const bf16_t*)(ws + WS_Z), (bf16_t*)(ws + WS_H)};
        pg8::gemm_phase<pg8::EpiMerge, true>(lds, g, S, E);
    }
    if (REP3 > 1) { GRID_SYNC(); {
        pg8::Gemm g{ZLD, 1024, 16, 128};
        pg8::Sched S; S.nM = T / 256; S.nN = 4; S.nwg = S.nM * S.nN; S.G = G; S.c = bx;
        S.A = (const char*)(ws + WS_Z) + ZC_O * 2; S.B = (const char*)(ws + WS_WCAT); S.tA = (size_t)256 * ZLD * 2; S.tB = (size_t)256 * 1024 * 2;
        S.nextra = 0; S.nN2 = 1; S.pnb2 = 0; S.A2 = S.A; S.B2 = S.B; S.tA2 = 0; S.tB2 = 0;
        pg8::EpiMerge E{(const bf16_t*)(ws + WS_Z), (bf16_t*)(ws + WS_H)};
        pg8::gemm_phase<pg8::EpiMerge, true>(lds, g, S, E);
    } }
    GRID_SYNC();
    if (PH_MASK & 64) {
        pg8::Gemm g{1024, 1024, 16, 128};
        pg8::Sched S; S.nM = T / 256; S.nN = 4; S.nwg = S.nM * S.nN; S.G = G; S.c = bx;
        S.A = (const char*)(ws + WS_H); S.B = (const char*)(ws + WS_WOUT); S.tA = (size_t)256 * 1024 * 2; S.tB = (size_t)256 * 1024 * 2;
        S.nextra = 0; S.nN2 = 1; S.pnb2 = 0; S.A2 = S.A; S.B2 = S.B; S.tA2 = 0; S.tB2 = 0;
        pg8::EpiX1 E{a.in[0], a.out, (bf16_t*)(ws + WS_X1B), (float*)(ws + WS_SUMSQ)};
        pg8::gemm_phase<pg8::EpiX1, true>(lds, g, S, E);
    }
    GRID_SYNC();
    if (PH_MASK & 128) {
        pg8::Gemm g{1024, 1024, 16, 128};
        pg8::Sched S; S.nM = T / 256; S.nN = FF / 256; S.nwg = S.nM * S.nN; S.G = G; S.c = bx;
        S.A = (const char*)(ws + WS_X1B); S.B = (const char*)(ws + WS_WUP); S.tA = (size_t)256 * 1024 * 2; S.tB = (size_t)256 * 1024 * 2;
        S.nextra = 0; S.nN2 = 1; S.pnb2 = 0; S.A2 = S.A; S.B2 = S.B; S.tA2 = 0; S.tB2 = 0;
        pg8::EpiUp E{(const float*)(ws + WS_SUMSQ), (bf16_t*)(ws + WS_U)};
        pg8::gemm_phase<pg8::EpiUp, true>(lds, g, S, E);
    }
    if (REP5 > 1) { GRID_SYNC(); {
        pg8::Gemm g{1024, 1024, 16, 128};
        pg8::Sched S; S.nM = T / 256; S.nN = FF / 256; S.nwg = S.nM * S.nN; S.G = G; S.c = bx;
        S.A = (const char*)(ws + WS_X1B); S.B = (const char*)(ws + WS_WUP); S.tA = (size_t)256 * 1024 * 2; S.tB = (size_t)256 * 1024 * 2;
        S.nextra = 0; S.nN2 = 1; S.pnb2 = 0; S.A2 = S.A; S.B2 = S.B; S.tA2 = 0; S.tB2 = 0;
        pg8::EpiUp E{(const float*)(ws + WS_SUMSQ), (bf16_t*)(ws + WS_U)};
        pg8::gemm_phase<pg8::EpiUp, true>(lds, g, S, E);
    } }
    GRID_SYNC();
    if (PH_MASK & 256) {
        pg8::Gemm g{64, FF, 64, 32768};
        pg8::Sched S; S.nM = T / 256; S.nN = 4; S.nwg = S.nM * S.nN; S.G = G; S.c = bx;
        S.A = (const char*)(ws + WS_U); S.B = (const char*)(ws + WS_WDOWN); S.tA = (size_t)256 * FF * 2; S.tB = (size_t)256 * FF * 2;
        S.nextra = 0; S.nN2 = 1; S.pnb2 = 0; S.A2 = S.A; S.B2 = S.B; S.tA2 = 0; S.tB2 = 0;
        pg8::EpiDown E{a.out, (const bf16_t*)(ws + WS_X1B)};
        pg8::gemm_phase<pg8::EpiDown, true>(lds, g, S, E);
    }
}

extern "C" void kernel_launch(void* const* d_in, const int* in_sizes, int n_in, void* d_out, int out_size, void* d_ws, size_t ws_size, hipStream_t stream) {
    static int grid = 0;
    if (grid == 0) {
        if (n_in != 23 || out_size != T * D || ws_size < WS_END) { fprintf(stderr, "kernel_launch: unexpected shapes (n_in %d out %d ws %zu)\n", n_in, out_size, ws_size); grid = -1; return; }
        int dev = 0, cus = 0, per_cu = 0;
        hipGetDevice(&dev);
        hipDeviceGetAttribute(&cus, hipDeviceAttributeMultiprocessorCount, dev);
        hipFuncSetAttribute((const void*)hybrid_fwd, hipFuncAttributeMaxDynamicSharedMemorySize, LDS_BYTES);
        hipOccupancyMaxActiveBlocksPerMultiprocessor(&per_cu, (const void*)hybrid_fwd, 512, LDS_BYTES);
        if (per_cu < 1) per_cu = 1;
        grid = cus * per_cu;
        (void)hipGetLastError();
    }
    if (grid < 0) return;
    if (hipMemsetAsync((char*)d_ws + WS_BAR, 0, 16384, stream) != hipSuccess) { fprintf(stderr, "kernel_launch: memset of the barrier words failed\n"); return; }
    Args a{};
    for (int i = 0; i < 23; ++i) a.in[i] = (const float*)d_in[i];
    a.out = (float*)d_out; a.ws = (unsigned char*)d_ws;
    void* args[] = {&a};
    hipError_t e = hipLaunchCooperativeKernel((const void*)hybrid_fwd, dim3(grid), dim3(512), args, LDS_BYTES, stream);
    if (e != hipSuccess) fprintf(stderr, "cooperative launch failed: %s (grid %d)\n", hipGetErrorString(e), grid);
}
```
